# Optimizing an MI355X kernel written in HIP

```python
import jax, jax.numpy as jnp
from jax import lax
import numpy as np

D_MODEL = 1024
BATCH = 4
SEQ = 8192
DEPTH = 2

HEAD_DIM = 64
N_HEADS = 16
DIL_WINDOWS = (128, 512, 2048)
DIL_RATES = (1, 4, 16)
N_DIL = 3
N_KV_HEADS = 2
CMP_STRIDE = 16
CMP_LEN = 32
CMP_HIDDEN = 128
SEL_BLOCK = 64
N_SELECT = 16
SLIDE_WINDOW = 512
D_FF = 2816
Q_BLOCK = 128
ROPE_THETA = 10000.0
EPS = 1e-6

kernel_name = 'yoco_dilated_nsa_macaron_adaln'


def rms_norm(x, g):
    xf = x.astype(jnp.float32)
    y = xf * lax.rsqrt(jnp.mean(xf * xf, axis=-1, keepdims=True) + EPS)
    return (y * g.astype(jnp.float32)).astype(x.dtype)


def modulate(x, shift, scale):
    return x * (1.0 + scale) + shift


def rope(x):
    s = x.shape[1]
    half = HEAD_DIM // 2
    inv = ROPE_THETA ** (-jnp.arange(half, dtype=jnp.float32) / half)
    ang = jnp.arange(s, dtype=jnp.float32)[:, None] * inv[None, :]
    cos = jnp.cos(ang)[None, :, None, :]
    sin = jnp.sin(ang)[None, :, None, :]
    xf = x.astype(jnp.float32)
    x1, x2 = xf[..., :half], xf[..., half:]
    return jnp.concatenate([x1 * cos - x2 * sin, x1 * sin + x2 * cos], axis=-1).astype(x.dtype)


def swiglu(x, w_in, w_out):
    g, u = jnp.split(x @ w_in, 2, axis=-1)
    return (jax.nn.silu(g) * u) @ w_out


def masked_softmax(s, mask):
    s = jnp.where(mask, s, -jnp.inf)
    m = jnp.max(s, axis=-1, keepdims=True)
    m = jnp.where(jnp.isfinite(m), m, 0.0)
    p = jnp.exp(s - m)
    return p / jnp.maximum(jnp.sum(p, axis=-1, keepdims=True), 1e-30)


def _ada(mod, s):
    return mod[:, s, 0][:, None, :], mod[:, s, 1][:, None, :], 1.0 + mod[:, s, 2][:, None, :]


def banded_causal_attention(q, k, v, n_back):
    n, h, l, hd = q.shape
    nb = -(-l // Q_BLOCK)
    lp = nb * Q_BLOCK
    front = (-(-n_back // Q_BLOCK)) * Q_BLOCK
    kw = front + Q_BLOCK
    qp = jnp.pad(q, ((0, 0), (0, 0), (0, lp - l), (0, 0)))
    kp = jnp.pad(k, ((0, 0), (0, 0), (front, lp - l), (0, 0)))
    vp = jnp.pad(v, ((0, 0), (0, 0), (front, lp - l), (0, 0)))
    qi = jnp.arange(Q_BLOCK)[:, None]
    ki = jnp.arange(kw)[None, :]
    dist = front + qi - ki
    band = (dist >= 0) & (dist <= n_back)
    scale = HEAD_DIM ** -0.5

    def step(bi):
        start = bi * Q_BLOCK
        qb = lax.dynamic_slice_in_dim(qp, start, Q_BLOCK, axis=2)
        kb = lax.dynamic_slice_in_dim(kp, start, kw, axis=2)
        vb = lax.dynamic_slice_in_dim(vp, start, kw, axis=2)
        s = jnp.einsum('nhqd,nhkd->nhqk', qb, kb).astype(jnp.float32) * scale
        s = jnp.where(band & (start - front + ki >= 0), s, -jnp.inf)
        m = jnp.max(s, axis=-1, keepdims=True)
        p = jnp.exp(s - m)
        den = jnp.sum(p, axis=-1, keepdims=True)
        o = jnp.einsum('nhqk,nhkd->nhqd', (p / den).astype(vb.dtype), vb)
        return o, (m + jnp.log(den))[..., 0]

    o, lse = lax.map(step, jnp.arange(nb))
    o = jnp.moveaxis(o, 0, 2).reshape(n, h, lp, hd)[:, :, :l]
    lse = jnp.moveaxis(lse, 0, 2).reshape(n, h, lp)[:, :, :l]
    return o, lse


def dilated_attention(q, k, v, window, rate):
    b, s, h, hd = q.shape
    l = s // rate

    def to_res(t):
        return t.reshape(b, l, rate, h, hd).transpose(0, 2, 3, 1, 4).reshape(b * rate, h, l, hd)

    o, lse = banded_causal_attention(to_res(q), to_res(k), to_res(v), window // rate)
    o = o.reshape(b, rate, h, l, hd).transpose(0, 3, 1, 2, 4).reshape(b, s, h, hd)
    lse = lse.reshape(b, rate, h, l).transpose(0, 3, 1, 2).reshape(b, s, h)
    return o, lse


def dilated_mixer(u, w_qkv, q_gain, k_gain, w_o):
    b, s, _ = u.shape
    qkv = (u @ w_qkv).reshape(b, s, N_DIL, 3, N_HEADS, HEAD_DIM)
    outs, lses = [], []
    for g in range(N_DIL):
        q = rope(rms_norm(qkv[:, :, g, 0], q_gain[g]))
        k = rope(rms_norm(qkv[:, :, g, 1], k_gain[g]))
        o, lse = dilated_attention(q, k, qkv[:, :, g, 2], DIL_WINDOWS[g], DIL_RATES[g])
        outs.append(o.astype(jnp.float32))
        lses.append(lse)
    w = jax.nn.softmax(jnp.stack(lses, axis=0), axis=0)
    o = jnp.sum(w[..., None] * jnp.stack(outs, axis=0), axis=0).astype(u.dtype)
    return o.reshape(b, s, N_HEADS * HEAD_DIM) @ w_o


def shared_kv(h, shift, scale, kv_norm_g, w_kv, kv_k_gain, cmp_pos, phi_w1, phi_w2):
    b, s, _ = h.shape
    u = modulate(rms_norm(h, kv_norm_g), shift, scale)
    kv = (u @ w_kv).reshape(b, s, 3, 2, N_KV_HEADS, HEAD_DIM)
    nsb = s // CMP_STRIDE
    nper = CMP_LEN // CMP_STRIDE
    n_c = nsb - nper + 1

    def compress(t, i):
        tb = t.reshape(b, nsb, CMP_STRIDE, N_KV_HEADS, HEAD_DIM)
        blocks = jnp.concatenate([tb[:, j:j + n_c] for j in range(nper)], axis=2)
        blocks = blocks + cmp_pos[i][None, None, :, None, :]
        flat = blocks.transpose(0, 1, 3, 2, 4).reshape(b, n_c, N_KV_HEADS, CMP_LEN * HEAD_DIM)
        return jax.nn.silu(flat @ phi_w1[i]) @ phi_w2[i]

    k_cmp = rms_norm(compress(kv[:, :, 0, 0], 0), kv_k_gain[0]).transpose(0, 2, 1, 3)
    v_cmp = compress(kv[:, :, 0, 1], 1).transpose(0, 2, 1, 3)
    n_s = s // SEL_BLOCK

    def to_blocks(t):
        return t.reshape(b, n_s, SEL_BLOCK, N_KV_HEADS, HEAD_DIM).transpose(0, 3, 1, 2, 4)

    k_slc = to_blocks(rope(rms_norm(kv[:, :, 1, 0], kv_k_gain[1])))
    v_slc = to_blocks(kv[:, :, 1, 1])
    pad = ((0, 0), (0, 0), (SLIDE_WINDOW, 0), (0, 0))
    k_win = jnp.pad(rope(rms_norm(kv[:, :, 2, 0], kv_k_gain[2])).transpose(0, 2, 1, 3), pad)
    v_win = jnp.pad(kv[:, :, 2, 1].transpose(0, 2, 1, 3), pad)
    return k_cmp, v_cmp, k_slc, v_slc, k_win, v_win


def block_importance(p, n_s):
    r = SEL_BLOCK // CMP_STRIDE
    nper = CMP_LEN // CMP_STRIDE
    left = nper - 1
    n_c = p.shape[-1]
    right = r * n_s + r - n_c
    pp = jnp.pad(p, [(0, 0)] * (p.ndim - 1) + [(left, right)])
    imp = None
    for o in range(-left, r):
        w = sum(1 for m in range(r) for n in range(nper) if m - n == o)
        sl = pp[..., o + left:o + left + r * n_s:r]
        imp = w * sl if imp is None else imp + w * sl
    return imp


def nsa_mixer(u, k_cmp, v_cmp, k_slc, v_slc, k_win, v_win, w_qg, q_gain, w_o):
    b, s, _ = u.shape
    grp = N_HEADS // N_KV_HEADS
    hdim = N_HEADS * HEAD_DIM
    qg = u @ w_qg
    q = rms_norm(qg[..., :hdim].reshape(b, s, N_HEADS, HEAD_DIM), q_gain)
    gates = jax.nn.sigmoid(qg[..., hdim:].astype(jnp.float32))
    gates = gates.reshape(b, s, 3, N_KV_HEADS, grp).transpose(2, 0, 3, 4, 1)

    def to_grp(t):
        return t.reshape(b, s, N_KV_HEADS, grp, HEAD_DIM).transpose(0, 2, 3, 1, 4)

    q_nope = to_grp(q)
    q_rope = to_grp(rope(q))
    n_c = k_cmp.shape[2]
    n_s = k_slc.shape[2]
    topk = min(N_SELECT, n_s)
    cmp_end = jnp.arange(n_c) * CMP_STRIDE + CMP_LEN - 1
    blk = jnp.arange(n_s)
    qi = jnp.arange(Q_BLOCK)
    ki = jnp.arange(SLIDE_WINDOW + Q_BLOCK)[None, :]
    wdist = SLIDE_WINDOW + qi[:, None] - ki
    wband = (wdist >= 0) & (wdist < SLIDE_WINDOW)
    bi_idx = jnp.arange(b)[:, None, None, None]
    hi_idx = jnp.arange(N_KV_HEADS)[None, :, None, None]
    scale = HEAD_DIM ** -0.5

    def step(bi):
        start = bi * Q_BLOCK
        t = start + qi
        qn = lax.dynamic_slice_in_dim(q_nope, start, Q_BLOCK, axis=3)
        qr = lax.dynamic_slice_in_dim(q_rope, start, Q_BLOCK, axis=3)
        gb = lax.dynamic_slice_in_dim(gates, start, Q_BLOCK, axis=4)
        sc = jnp.einsum('bkgqd,bkcd->bkgqc', qn, k_cmp).astype(jnp.float32) * scale
        p_cmp = masked_softmax(sc, cmp_end[None, :] <= t[:, None])
        o_cmp = jnp.einsum('bkgqc,bkcd->bkgqd', p_cmp.astype(v_cmp.dtype), v_cmp)
        imp = block_importance(jnp.sum(p_cmp, axis=2), n_s)
        jt = (t // SEL_BLOCK)[:, None]
        forced = (blk == 0) | (blk == jt) | (blk == jt - 1)
        imp = jnp.where(blk > jt, -jnp.inf, jnp.where(forced, jnp.inf, imp))
        _, idx = lax.top_k(imp, topk)
        ks = k_slc[bi_idx, hi_idx, idx].reshape(b, N_KV_HEADS, Q_BLOCK, topk * SEL_BLOCK, HEAD_DIM)
        vs = v_slc[bi_idx, hi_idx, idx].reshape(b, N_KV_HEADS, Q_BLOCK, topk * SEL_BLOCK, HEAD_DIM)
        kpos = (idx[..., None] * SEL_BLOCK + jnp.arange(SEL_BLOCK)).reshape(b, N_KV_HEADS, Q_BLOCK, topk * SEL_BLOCK)
        ss = jnp.einsum('bkgqd,bkqnd->bkgqn', qr, ks).astype(jnp.float32) * scale
        p_s = masked_softmax(ss, (kpos <= t[:, None])[:, :, None])
        o_slc = jnp.einsum('bkgqn,bkqnd->bkgqd', p_s.astype(vs.dtype), vs)
        kw = lax.dynamic_slice_in_dim(k_win, start, SLIDE_WINDOW + Q_BLOCK, axis=2)
        vw = lax.dynamic_slice_in_dim(v_win, start, SLIDE_WINDOW + Q_BLOCK, axis=2)
        sw = jnp.einsum('bkgqd,bknd->bkgqn', qr, kw).astype(jnp.float32) * scale
        p_w = masked_softmax(sw, wband & (start - SLIDE_WINDOW + ki >= 0))
        o_win = jnp.einsum('bkgqn,bknd->bkgqd', p_w.astype(vw.dtype), vw)
        o = gb[0][..., None] * o_cmp + gb[1][..., None] * o_slc + gb[2][..., None] * o_win
        return o.astype(u.dtype)

    o = lax.map(step, jnp.arange(s // Q_BLOCK))
    o = o.transpose(1, 0, 4, 2, 3, 5).reshape(b, s, hdim)
    return o @ w_o


def setup_inputs(seed: int = 0) -> dict:
    key = jax.random.key(seed)
    ks = jax.random.split(key, 22)
    n_a = DEPTH // 2
    n_b = DEPTH - n_a
    d = D_MODEL
    hdim = N_HEADS * HEAD_DIM

    def nrm(k, shape, fan_in, gain=1.0):
        return jax.random.normal(k, shape, jnp.float32) * (gain * fan_in ** -0.5)

    def gain_init(k, shape):
        return 1.0 + 0.02 * jax.random.normal(k, shape, jnp.float32)

    return {
        'x': jax.random.normal(ks[0], (BATCH, SEQ, d), jnp.float32),
        'c': jax.random.normal(ks[1], (BATCH, d), jnp.float32),
        'norm_g': gain_init(ks[2], (DEPTH, 3, d)),
        'w_ada': nrm(ks[3], (DEPTH, d, 9 * d), d, 0.1),
        'b_ada': 0.01 * jax.random.normal(ks[4], (DEPTH, 9 * d), jnp.float32),
        'ffn_w_in': nrm(ks[5], (DEPTH, 2, d, 2 * D_FF), d),
        'ffn_w_out': nrm(ks[6], (DEPTH, 2, D_FF, d), D_FF),
        'a_w_qkv': nrm(ks[7], (n_a, d, N_DIL * 3 * hdim), d),
        'a_q_gain': gain_init(ks[8], (n_a, N_DIL, HEAD_DIM)),
        'a_k_gain': gain_init(ks[9], (n_a, N_DIL, HEAD_DIM)),
        'a_w_o': nrm(ks[10], (n_a, hdim, d), hdim),
        'kv_norm_g': gain_init(ks[11], (d,)),
        'w_ada_kv': nrm(ks[12], (d, 2 * d), d, 0.1),
        'b_ada_kv': 0.01 * jax.random.normal(ks[13], (2 * d,), jnp.float32),
        'w_kv': nrm(ks[14], (d, 3 * 2 * N_KV_HEADS * HEAD_DIM), d),
        'kv_k_gain': gain_init(ks[15], (3, HEAD_DIM)),
        'cmp_pos': 0.1 * jax.random.normal(ks[16], (2, CMP_LEN, HEAD_DIM), jnp.float32),
        'phi_w1': nrm(ks[17], (2, CMP_LEN * HEAD_DIM, CMP_HIDDEN), CMP_LEN * HEAD_DIM),
        'phi_w2': nrm(ks[18], (2, CMP_HIDDEN, HEAD_DIM), CMP_HIDDEN),
        'b_w_qg': nrm(ks[19], (n_b, d, hdim + 3 * N_HEADS), d),
        'b_q_gain': gain_init(ks[20], (n_b, HEAD_DIM)),
        'b_w_o': nrm(ks[21], (n_b, hdim, d), hdim),
    }


def reference(x, c, norm_g, w_ada, b_ada, ffn_w_in, ffn_w_out, a_w_qkv, a_q_gain, a_k_gain, a_w_o,
              kv_norm_g, w_ada_kv, b_ada_kv, w_kv, kv_k_gain, cmp_pos, phi_w1, phi_w2,
              b_w_qg, b_q_gain, b_w_o):
    n_a = DEPTH // 2
    bsz = x.shape[0]
    c_act = jax.nn.silu(c)
    h = x
    shared = None
    for l in range(DEPTH):
        mod = (c_act @ w_ada[l] + b_ada[l]).reshape(bsz, 3, 3, D_MODEL)
        sh, sc, gt = _ada(mod, 0)
        h = h + 0.5 * gt * swiglu(modulate(rms_norm(h, norm_g[l, 0]), sh, sc), ffn_w_in[l, 0], ffn_w_out[l, 0])
        sh, sc, gt = _ada(mod, 1)
        u = modulate(rms_norm(h, norm_g[l, 1]), sh, sc)
        if l < n_a:
            y = dilated_mixer(u, a_w_qkv[l], a_q_gain[l], a_k_gain[l], a_w_o[l])
        else:
            j = l - n_a
            y = nsa_mixer(u, *shared, b_w_qg[j], b_q_gain[j], b_w_o[j])
        h = h + gt * y
        sh, sc, gt = _ada(mod, 2)
        h = h + 0.5 * gt * swiglu(modulate(rms_norm(h, norm_g[l, 2]), sh, sc), ffn_w_in[l, 1], ffn_w_out[l, 1])
        if l == n_a - 1:
            kv_mod = (c_act @ w_ada_kv + b_ada_kv).reshape(bsz, 2, D_MODEL)
            shared = shared_kv(h, kv_mod[:, 0][:, None, :], kv_mod[:, 1][:, None, :], kv_norm_g, w_kv,
                               kv_k_gain, cmp_pos, phi_w1, phi_w2)
    return h
```

```cpp
#include <hip/hip_runtime.h>
#include <hip/hip_cooperative_groups.h>
#include <cstdio>
#include <cstring>
namespace cg = cooperative_groups;

#define DI __device__ __forceinline__
#define LAS __attribute__((address_space(3)))
typedef unsigned short bf16_t;
typedef short bf16x8 __attribute__((ext_vector_type(8)));
typedef short s16x4 __attribute__((ext_vector_type(4)));
typedef float f32x2 __attribute__((ext_vector_type(2)));
typedef float f32x4 __attribute__((ext_vector_type(4)));
typedef float f32x16 __attribute__((ext_vector_type(16)));
typedef unsigned u32x2 __attribute__((ext_vector_type(2)));
typedef unsigned u32x4 __attribute__((ext_vector_type(4)));
typedef __bf16 bf16x2_t __attribute__((ext_vector_type(2)));

constexpr int NB = 4, SEQ = 8192, DM = 1024, NTOK = NB * SEQ, DFF = 2816;
constexpr int MODW = 20480;
constexpr float EPSN = 1e-6f;
constexpr float SC2 = 0.125f * 1.44269504088896f;
constexpr float LN2 = 0.69314718055994531f;
constexpr int LDS_BYTES = 163840;
constexpr int BV_FFN = 4 * 5632, BV_QKV = 4 * BV_FFN, BV_KV = BV_QKV + 4 * 9216, BV_QG = BV_KV + 4 * 768;

constexpr size_t MiB = 1ull << 20;
constexpr size_t WS_WIN = 0;
constexpr size_t WS_WOUT = 44 * MiB;
constexpr size_t WS_WQKV = 66 * MiB;
constexpr size_t WS_WOA = 84 * MiB;
constexpr size_t WS_WKV = 86 * MiB;
constexpr size_t WS_WQG = 88 * MiB;
constexpr size_t WS_WOB = 91 * MiB;
constexpr size_t WS_WPHI1 = 93 * MiB;
constexpr size_t WS_WPHI2 = 95 * MiB;
constexpr size_t WS_MODP = 96 * MiB;
constexpr size_t WS_SSPA = 96 * MiB;
constexpr size_t WS_SSPB = 98 * MiB;
constexpr size_t WS_BV = 100 * MiB;
constexpr size_t WS_GS = 100 * MiB + 768 * 1024;
constexpr size_t WS_MODF = 101 * MiB;
constexpr size_t WS_ROPEC = 102 * MiB;
constexpr size_t WS_ROPES = 103 * MiB;
constexpr size_t WS_BIAS1 = 104 * MiB;
constexpr size_t WS_LSE = 105 * MiB;
constexpr size_t WS_GATES = 106 * MiB;
constexpr size_t WS_H16 = 112 * MiB;
constexpr size_t WS_BIG = 176 * MiB;
constexpr size_t WS_HID = WS_BIG;
constexpr size_t WS_QKVG = WS_BIG;
constexpr size_t WS_OACC = 368 * MiB;
constexpr size_t WS_UKV = 352 * MiB;
constexpr size_t WS_KV = 416 * MiB;
constexpr size_t WS_HC = 466 * MiB;
constexpr size_t WS_CMP = 470 * MiB;
constexpr size_t WS_QN = WS_BIG;
constexpr size_t WS_QR = 240 * MiB;
constexpr size_t WS_BAR = 472 * MiB;
constexpr size_t WS_NEED = 473 * MiB;

struct Job { const float* src; bf16_t* dst; int nsrc, ksrc, kdst, ndst, perm, pad; };
constexpr int NJOBS = 17;
struct Params {
    const float *x, *c, *norm_g, *w_ada, *b_ada, *ffn_w_in, *ffn_w_out, *a_w_qkv, *a_q_gain, *a_k_gain, *a_w_o, *kv_norm_g, *w_ada_kv,
        *b_ada_kv, *w_kv, *kv_k_gain, *cmp_pos, *phi_w1, *phi_w2, *b_w_qg, *b_q_gain, *b_w_o;
    float* out; unsigned char* ws;
    int ph_lo, ph_hi;
    Job jobs[NJOBS];
};

typedef const __attribute__((address_space(4))) Params* KP;
DI unsigned pk2(float a, float b) { f32x2 f = {a, b}; bf16x2_t v = __builtin_convertvector(f, bf16x2_t); return __builtin_bit_cast(unsigned, v); }
typedef _Float16 h16x2 __attribute__((ext_vector_type(2)));
DI unsigned pkh2(float a, float b) { f32x2 f = {a, b}; h16x2 v = __builtin_convertvector(f, h16x2); return __builtin_bit_cast(unsigned, v); }
DI float h_lo(unsigned u) { h16x2 v = __builtin_bit_cast(h16x2, u); return (float)v[0]; }
DI float h_hi(unsigned u) { h16x2 v = __builtin_bit_cast(h16x2, u); return (float)v[1]; }
DI float bf_lo(unsigned u) { return __uint_as_float(u << 16); }
DI float bf_hi(unsigned u) { return __uint_as_float(u & 0xffff0000u); }
DI float wave_sum(float v) { for (int o = 32; o >= 1; o >>= 1) v += __shfl_xor(v, o, 64); return v; }
DI float sum8(float v) {
    v += __int_as_float(__builtin_amdgcn_update_dpp(0, __float_as_int(v), 0x141, 0xf, 0xf, true));
    v += __int_as_float(__builtin_amdgcn_update_dpp(0, __float_as_int(v), 0xB1, 0xf, 0xf, true));
    v += __int_as_float(__builtin_amdgcn_update_dpp(0, __float_as_int(v), 0x4E, 0xf, 0xf, true));
    return v;
}
DI int crow(int i, int h) { return (i & 3) + 8 * (i >> 2) + 4 * h; }

namespace pg8 {
constexpr int BM = 256, BK = 64, HALF = 128, HTB = HALF * BK * 2, STAGE_BYTES = 8 * HTB, NXCD = 8, WGM = 8;
DI int lds_byte(int r, int c) { const int st = (r >> 4) * 2 + (c >> 5), rr = r & 15, cc = c & 31, ob = rr * 64 + cc * 2; return st * 1024 + (ob ^ (((ob >> 9) & 1) << 5)); }
DI void stage_rc(int b, int& R, int& C) { const int st = b / 1024, sb = b % 1024, swz = sb ^ (((sb >> 9) & 1) << 5); R = (st >> 1) * 16 + swz / 64; C = (st & 1) * 32 + (swz % 64) / 2; }
DI int perm32(int rho) { const int n = rho >> 4, i = rho & 15; return 8 * (i >> 2) + 4 * n + (i & 3); }
struct Unit { int pm, pn; };
struct Gemm { const bf16_t* A; const bf16_t* Bt; int M, N, K, lda, ldb; size_t kstepA, hstepA, tstepA; };
struct StaticOrder {
    int nM, nN, nwg, G, c;
    DI void init(int M, int N, int G_, int c_) { nM = M / BM; nN = N / BM; nwg = nM * nN; G = G_; c = c_; }
    DI bool next(int i, Unit& u) const {
        const long L = (long)i * G + c; if (L >= nwg) return false;
        int wgid = (int)L; { const int q = nwg / NXCD, r = nwg % NXCD, xcd = wgid % NXCD, off = wgid / NXCD; wgid = (xcd < r ? xcd * (q + 1) : r * (q + 1) + (xcd - r) * q) + off; }
        const int nig = WGM * nN, gid = wgid / nig, fm = gid * WGM, gsz = (nM - fm) < WGM ? (nM - fm) : WGM;
        u.pm = fm + ((wgid % nig) % gsz); u.pn = (wgid % nig) / gsz; return true;
    }
};
template <class Epi>
DI void gemm_phase(LAS unsigned char* lds, const Gemm g, const StaticOrder& S, const Epi& E, const int tid) {
    const int wid = __builtin_amdgcn_readfirstlane(tid >> 6), lane = tid & 63, wr = wid >> 2, wc = wid & 3, fr = lane & 15, fq = lane >> 4;
    const int K = g.K, nt = K / BK;
    unsigned voffA[2], voffB[2];
#pragma unroll
    for (int i = 0; i < 2; ++i) { int R, C; stage_rc(tid * 16 + i * 8192, R, C); const int Rb = (R & ~31) + perm32(R & 31);
        voffA[i] = (unsigned)(R * g.lda + C) * 2u; voffB[i] = (unsigned)(Rb * g.ldb + C) * 2u; }
    const size_t kstep = (size_t)(BK * 2), kstepA = g.kstepA;
    const size_t hstepA = g.hstepA, hstepB = (size_t)HALF * g.ldb * 2;
    const size_t tstepA = g.tstepA, tstepB = 2 * hstepB;
    const unsigned ldsw = (unsigned)wid * 1024u;
    const int aoff = lds_byte(wr * 64 + fr, fq * 8), boff = lds_byte(wc * 32 + fr, fq * 8);
#define PG8_SA(b, h) (((b) * 2 + (h)) * HTB)
#define PG8_SB(b, h) ((4 + (b) * 2 + (h)) * HTB)
#define PG8_STAGE(bufoff, gbase, voff) do { _Pragma("unroll") for (int _i = 0; _i < 2; ++_i) \
        __builtin_amdgcn_global_load_lds((const unsigned*)((const char*)(gbase) + (voff)[_i]), (LAS unsigned*)(lds + (bufoff) + ldsw + _i * 8192), 16, 0, 0); } while (0)
#define PG8_LDA(dst, b, h) do { _Pragma("unroll") for (int m = 0; m < 4; ++m) _Pragma("unroll") for (int k = 0; k < 2; ++k) dst[m][k] = *(const LAS bf16x8*)(lds + PG8_SA(b, h) + aoff + m * 2048 + k * 1024); } while (0)
#define PG8_LDB(dst, b, h) do { _Pragma("unroll") for (int n = 0; n < 2; ++n) _Pragma("unroll") for (int k = 0; k < 2; ++k) dst[n][k] = *(const LAS bf16x8*)(lds + PG8_SB(b, h) + boff + n * 2048 + k * 1024); } while (0)
#define PG8_MMA(ai, bj, At, Bt) do { __builtin_amdgcn_s_setprio(1); _Pragma("unroll") for (int m = 0; m < 4; ++m) _Pragma("unroll") for (int n = 0; n < 2; ++n) _Pragma("unroll") for (int k = 0; k < 2; ++k) \
        acc[ai][bj][m][n] = __builtin_amdgcn_mfma_f32_16x16x32_bf16(Bt[n][k], At[m][k], acc[ai][bj][m][n], 0, 0, 0); __builtin_amdgcn_s_setprio(0); } while (0)
#define PG8_WAIT_V(n) asm volatile("s_waitcnt vmcnt(" #n ")" ::: "memory")
#define PG8_WAIT_L(n) asm volatile("s_waitcnt lgkmcnt(" #n ")" ::: "memory")
#define PG8_BAR __builtin_amdgcn_s_barrier()
#define PG8_SCHED __builtin_amdgcn_sched_barrier(0)
    Unit cur, nxt; int ui = 0;
    if (!S.next(0, cur)) return;
    f32x4 acc[2][2][4][2];
#pragma unroll
    for (int a = 0; a < 2; ++a)
#pragma unroll
        for (int b = 0; b < 2; ++b)
#pragma unroll
            for (int m = 0; m < 4; ++m)
#pragma unroll
                for (int n = 0; n < 2; ++n) acc[a][b][m][n] = (f32x4){0.f, 0.f, 0.f, 0.f};
    bf16x8 At[4][2], B0[2][2], B1[2][2];
    const char* cA = (const char*)g.A + (size_t)cur.pm * tstepA; const char* cB = (const char*)g.Bt + (size_t)cur.pn * tstepB;
    PG8_STAGE(PG8_SB(0, 0), cB, voffB); PG8_STAGE(PG8_SA(0, 0), cA, voffA); PG8_STAGE(PG8_SB(0, 1), cB + hstepB, voffB); PG8_STAGE(PG8_SA(0, 1), cA + hstepA, voffA);
    if (wr == 1) PG8_BAR;
    PG8_WAIT_V(4); PG8_BAR;
    PG8_STAGE(PG8_SB(1, 0), cB + kstep, voffB); PG8_STAGE(PG8_SA(1, 0), cA + kstepA, voffA); PG8_STAGE(PG8_SB(1, 1), cB + hstepB + kstep, voffB);
    PG8_WAIT_V(6); PG8_BAR;
    for (;;) {
        const bool has_next = S.next(ui + 1, nxt);
        const char* nA = has_next ? (const char*)g.A + (size_t)nxt.pm * tstepA : cA; const char* nB = has_next ? (const char*)g.Bt + (size_t)nxt.pn * tstepB : cB;
        for (int t = 0; t < nt; t += 2) {
            const bool last = (t == nt - 2);
            const char* a1 = cA + (size_t)(t + 1) * kstepA;
            const char* a2 = last ? nA : cA + (size_t)(t + 2) * kstepA; const char* b2 = last ? nB : cB + (size_t)(t + 2) * kstep;
            const char* a3 = a2 + kstepA; const char* b3 = b2 + kstep;
            PG8_LDB(B0, 0, 0); PG8_SCHED; PG8_LDA(At, 0, 0); PG8_STAGE(PG8_SA(1, 1), a1 + hstepA, voffA);
            PG8_WAIT_L(8); PG8_BAR; PG8_WAIT_L(0); PG8_MMA(0, 0, At, B0); PG8_BAR; PG8_SCHED;
            PG8_LDB(B1, 0, 1); PG8_STAGE(PG8_SB(0, 0), b2, voffB);
            PG8_BAR; PG8_WAIT_L(0); PG8_MMA(0, 1, At, B1); PG8_BAR;
            PG8_LDA(At, 0, 1); PG8_STAGE(PG8_SA(0, 0), a2, voffA);
            PG8_BAR; PG8_WAIT_L(0); PG8_MMA(1, 0, At, B0); PG8_BAR; PG8_SCHED;
            PG8_STAGE(PG8_SB(0, 1), b2 + hstepB, voffB);
            PG8_WAIT_V(6); PG8_BAR; PG8_MMA(1, 1, At, B1); PG8_BAR;
            PG8_LDB(B0, 1, 0); PG8_SCHED; PG8_LDA(At, 1, 0); PG8_STAGE(PG8_SA(0, 1), a2 + hstepA, voffA);
            PG8_WAIT_L(8); PG8_BAR; PG8_WAIT_L(0); PG8_MMA(0, 0, At, B0); PG8_BAR; PG8_SCHED;
            PG8_LDB(B1, 1, 1); PG8_STAGE(PG8_SB(1, 0), b3, voffB);
            PG8_BAR; PG8_WAIT_L(0); PG8_MMA(0, 1, At, B1); PG8_BAR;
            PG8_LDA(At, 1, 1); PG8_STAGE(PG8_SA(1, 0), a3, voffA);
            PG8_BAR; PG8_WAIT_L(0); PG8_MMA(1, 0, At, B0); PG8_BAR; PG8_SCHED;
            PG8_STAGE(PG8_SB(1, 1), b3 + hstepB, voffB);
            PG8_WAIT_V(6); PG8_BAR; PG8_MMA(1, 1, At, B1); PG8_BAR;
        }
        { int fr_e = fr, fq_e = fq; asm volatile("" : "+v"(fr_e), "+v"(fq_e)); E(acc, cur, wr, wc, fr_e, fq_e); }
        if (!has_next) break;
#pragma unroll
        for (int a = 0; a < 2; ++a)
#pragma unroll
            for (int b = 0; b < 2; ++b)
#pragma unroll
                for (int m = 0; m < 4; ++m)
#pragma unroll
                    for (int n = 0; n < 2; ++n) acc[a][b][m][n] = (f32x4){0.f, 0.f, 0.f, 0.f};
        cur = nxt; cA = nA; cB = nB; ++ui;
    }
    PG8_WAIT_V(0);
    if (wr == 0) PG8_BAR;
    PG8_BAR;
#undef PG8_SA
#undef PG8_SB
#undef PG8_STAGE
#undef PG8_LDA
#undef PG8_LDB
#undef PG8_MMA
#undef PG8_WAIT_V
#undef PG8_WAIT_L
#undef PG8_BAR
#undef PG8_SCHED
}
}
using pg8::Unit;
typedef f32x4 AccT[2][2][4][2];

DI void head_norm_rope(float (&v)[2][8], const float* gain, bool do_rope, int pos, int fq, const float* cosT, const float* sinT) {
    float ss = 0.f;
#pragma unroll
    for (int bj = 0; bj < 2; ++bj)
#pragma unroll
        for (int e = 0; e < 8; ++e) ss += v[bj][e] * v[bj][e];
    ss += __shfl_xor(ss, 16, 64); ss += __shfl_xor(ss, 32, 64);
    const float rinv = rsqrtf(ss * (1.0f / 64.0f) + EPSN);
#pragma unroll
    for (int bj = 0; bj < 2; ++bj) {
        const f32x4 g0 = *(const f32x4*)(gain + 32 * bj + 8 * fq), g1 = *(const f32x4*)(gain + 32 * bj + 8 * fq + 4);
#pragma unroll
        for (int e = 0; e < 4; ++e) { v[bj][e] = v[bj][e] * rinv * g0[e]; v[bj][4 + e] = v[bj][4 + e] * rinv * g1[e]; }
    }
    if (do_rope) {
        const f32x4 c0 = *(const f32x4*)(cosT + pos * 32 + 8 * fq), c1 = *(const f32x4*)(cosT + pos * 32 + 8 * fq + 4);
        const f32x4 s0 = *(const f32x4*)(sinT + pos * 32 + 8 * fq), s1 = *(const f32x4*)(sinT + pos * 32 + 8 * fq + 4);
#pragma unroll
        for (int e = 0; e < 8; ++e) { const float c = e < 4 ? c0[e & 3] : c1[e & 3], s = e < 4 ? s0[e & 3] : s1[e & 3];
            const float x1 = v[0][e], x2 = v[1][e]; v[0][e] = x1 * c - x2 * s; v[1][e] = x1 * s + x2 * c; }
    }
}
DI u32x4 pack8(const float* v) { u32x4 w; w.x = pk2(v[0], v[1]); w.y = pk2(v[2], v[3]); w.z = pk2(v[4], v[5]); w.w = pk2(v[6], v[7]); return w; }
#define ACC16(v, acc, ai, m) _Pragma("unroll") for (int bj = 0; bj < 2; ++bj) _Pragma("unroll") for (int n = 0; n < 2; ++n) _Pragma("unroll") for (int j = 0; j < 4; ++j) v[bj][4 * n + j] = acc[ai][bj][m][n][j]

DI float row_rinv(const float* ss, int row) { return rsqrtf(ss[row] * (1.0f / DM) + EPSN); }
#define ACC16B(v, acc, ai, m, ri, b00, b01, b10, b11) _Pragma("unroll") for (int j = 0; j < 4; ++j) { v[0][j] = fmaf(acc[ai][0][m][0][j], ri, b00[j]); v[0][4 + j] = fmaf(acc[ai][0][m][1][j], ri, b01[j]); v[1][j] = fmaf(acc[ai][1][m][0][j], ri, b10[j]); v[1][4 + j] = fmaf(acc[ai][1][m][1][j], ri, b11[j]); }
#define LOAD_RI(ri, ssp, row0) float ri[8]; _Pragma("unroll") for (int q_ = 0; q_ < 8; ++q_) ri[q_] = row_rinv(ssp, (row0) + (q_ >> 2) * 128 + (q_ & 3) * 16)
#define LOAD_B4(bp) const f32x4 b00 = *(const f32x4*)(bp), b01 = *(const f32x4*)((bp) + 4), b10 = *(const f32x4*)((bp) + 32), b11 = *(const f32x4*)((bp) + 36)
struct EpiSwiGLU {
    bf16_t* hid; const float* ssp; const float* bias;
    DI void operator()(const AccT& acc, const Unit& u, int wr, int wc, int fr, int fq) const {
        const int row0 = u.pm * 256 + wr * 64 + fr, col0 = u.pn * 128 + wc * 32 + 8 * fq;
        const float* bp = bias + (size_t)((u.pm * 256) >> 13) * 5632 + col0;
        const f32x4 b00 = *(const f32x4*)(bp), b01 = *(const f32x4*)(bp + 4), b10 = *(const f32x4*)(bp + DFF), b11 = *(const f32x4*)(bp + DFF + 4);
        LOAD_RI(ri, ssp, row0);
#pragma unroll
        for (int ai = 0; ai < 2; ++ai)
#pragma unroll
            for (int m = 0; m < 4; ++m) { __builtin_amdgcn_sched_barrier(0); const int row = row0 + ai * 128 + m * 16; float v[2][8]; ACC16B(v, acc, ai, m, ri[ai * 4 + m], b00, b01, b10, b11);
                float o[8];
#pragma unroll
                for (int e = 0; e < 8; ++e) o[e] = v[0][e] * __builtin_amdgcn_rcpf(1.0f + __expf(-v[0][e])) * v[1][e];
                __builtin_nontemporal_store(pack8(o), (u32x4*)(hid + ((size_t)(row >> 8) * (DFF / 64) + (col0 >> 6)) * (256 * 64) + (size_t)(row & 255) * 64 + (col0 & 63))); }
    }
};
#define RESID_ROW(q) (row0 + ((q) >> 2) * 128 + ((q) & 3) * 16)
template <bool INF32> struct ResidIn {
    u32x4 a, b;
    DI void load(const void* hin, size_t off) { if (INF32) { a = *(const u32x4*)((const float*)hin + off); b = *(const u32x4*)((const float*)hin + off + 4); } else a = *(const u32x4*)((const unsigned short*)hin + off); }
    DI void get(float (&v)[8]) const { if (INF32) { v[0] = __uint_as_float(a.x); v[1] = __uint_as_float(a.y); v[2] = __uint_as_float(a.z); v[3] = __uint_as_float(a.w); v[4] = __uint_as_float(b.x); v[5] = __uint_as_float(b.y); v[6] = __uint_as_float(b.z); v[7] = __uint_as_float(b.w); }
        else { v[0] = h_lo(a.x); v[1] = h_hi(a.x); v[2] = h_lo(a.y); v[3] = h_hi(a.y); v[4] = h_lo(a.z); v[5] = h_hi(a.z); v[6] = h_lo(a.w); v[7] = h_hi(a.w); } }
};
struct EpiResid {
    const unsigned short* hin; float* hout; const float* gate; float coef;
    DI void operator()(const AccT& acc, const Unit& u, int wr, int wc, int fr, int fq) const {
        const int row0 = u.pm * 256 + wr * 64 + fr, col0 = u.pn * 256 + wc * 32 + 8 * fq;
        const float* gp = gate + (size_t)((u.pm * 256) >> 13) * MODW + col0;
        f32x4 cg[2][2]; ResidIn<false> hv[2], hn[2];
#pragma unroll
        for (int bj = 0; bj < 2; ++bj)
#pragma unroll
            for (int n = 0; n < 2; ++n) { const f32x4 gt = *(const f32x4*)(gp + 128 * bj + 4 * n); cg[bj][n] = coef * (1.0f + gt); }
        hv[0].load(hin, (size_t)RESID_ROW(0) * DM + col0); hv[1].load(hin, (size_t)RESID_ROW(0) * DM + col0 + 128);
#pragma unroll
        for (int q = 0; q < 8; ++q) { __builtin_amdgcn_sched_barrier(0); const int ai = q >> 2, m = q & 3; const int row = RESID_ROW(q);
            if (q < 7) { hn[0].load(hin, (size_t)RESID_ROW(q + 1) * DM + col0); hn[1].load(hin, (size_t)RESID_ROW(q + 1) * DM + col0 + 128); }
#pragma unroll
            for (int bj = 0; bj < 2; ++bj) { float hvv[8]; hv[bj].get(hvv);
#pragma unroll
                for (int n = 0; n < 2; ++n) { f32x4 r;
#pragma unroll
                    for (int j = 0; j < 4; ++j) r[j] = fmaf(cg[bj][n][j], acc[ai][bj][m][n][j], hvv[4 * n + j]);
                    *(f32x4*)(hout + (size_t)row * DM + col0 + 128 * bj + 4 * n) = r; } }
            hv[0] = hn[0]; hv[1] = hn[1];
        }
    }
};
template <bool DUAL, bool INF32> struct EpiResidN {
    const void* hin; unsigned short* hout; const float* gate; float coef; float* ss; bf16_t* a1; const float* gs1; bf16_t* a2; const float* gs2;
    DI void operator()(const AccT& acc, const Unit& u, int wr, int wc, int fr, int fq) const {
        const int row0 = u.pm * 256 + wr * 64 + fr, col0 = u.pn * 256 + wc * 32 + 8 * fq; const int b = (u.pm * 256) >> 13;
        const float* gp = gate + (size_t)b * MODW + col0; const float* g1p = gs1 + b * DM + col0; const float* g2p = gs2 + b * DM + col0;
        f32x4 cg[2][2], ga[2][2]; ResidIn<INF32> hv[2], hn[2];
#pragma unroll
        for (int bj = 0; bj < 2; ++bj)
#pragma unroll
            for (int n = 0; n < 2; ++n) { const f32x4 gt = *(const f32x4*)(gp + 128 * bj + 4 * n); cg[bj][n] = coef * (1.0f + gt); ga[bj][n] = *(const f32x4*)(g1p + 128 * bj + 4 * n); }
        hv[0].load(hin, (size_t)RESID_ROW(0) * DM + col0); hv[1].load(hin, (size_t)RESID_ROW(0) * DM + col0 + 128);
#pragma unroll
        for (int q = 0; q < 8; ++q) { __builtin_amdgcn_sched_barrier(0); const int ai = q >> 2, m = q & 3; const int row = RESID_ROW(q); float ssr = 0.f;
            if (q < 7) { hn[0].load(hin, (size_t)RESID_ROW(q + 1) * DM + col0); hn[1].load(hin, (size_t)RESID_ROW(q + 1) * DM + col0 + 128); }
#pragma unroll
            for (int bj = 0; bj < 2; ++bj) { const int col = col0 + 128 * bj; float o1[8], o2[8], rr[8], hvv[8]; hv[bj].get(hvv);
#pragma unroll
                for (int n = 0; n < 2; ++n) { f32x4 gbv = {0.f, 0.f, 0.f, 0.f}; if (DUAL) gbv = *(const f32x4*)(g2p + 128 * bj + 4 * n);
#pragma unroll
                    for (int j = 0; j < 4; ++j) { const float r = fmaf(cg[bj][n][j], acc[ai][bj][m][n][j], hvv[4 * n + j]); rr[4 * n + j] = r; ssr = fmaf(r, r, ssr); o1[4 * n + j] = r * ga[bj][n][j]; if (DUAL) o2[4 * n + j] = r * gbv[j]; } }
                *(u32x4*)(hout + (size_t)row * DM + col) = (u32x4){pkh2(rr[0], rr[1]), pkh2(rr[2], rr[3]), pkh2(rr[4], rr[5]), pkh2(rr[6], rr[7])};
                *(u32x4*)(a1 + (size_t)row * DM + col) = pack8(o1);
                if (DUAL) *(u32x4*)(a2 + (size_t)row * DM + col) = pack8(o2); }
            ssr += __shfl_xor(ssr, 16, 64); ssr += __shfl_xor(ssr, 32, 64);
            if (fq == 0) unsafeAtomicAdd(ss + row, ssr);
            hv[0] = hn[0]; hv[1] = hn[1];
        }
    }
};
struct EpiQKV {
    bf16_t* dst; const float *qgain, *kgain, *cosT, *sinT; const float* ssp; const float* bias; int gofs;
    DI void operator()(const AccT& acc, const Unit& u, int wr, int wc, int fr, int fq) const {
        const int slot = 4 * u.pn + wc, type = slot >> 4; const int row0 = u.pm * 256 + wr * 64 + fr;
        const float* gain = type == 0 ? qgain : kgain;
        const float* bp = bias + (size_t)((u.pm * 256) >> 13) * 9216 + gofs + slot * 64 + 8 * fq; LOAD_B4(bp); LOAD_RI(ri, ssp, row0);
#pragma unroll
        for (int ai = 0; ai < 2; ++ai)
#pragma unroll
            for (int m = 0; m < 4; ++m) { __builtin_amdgcn_sched_barrier(0); const int row = row0 + ai * 128 + m * 16; float v[2][8]; ACC16B(v, acc, ai, m, ri[ai * 4 + m], b00, b01, b10, b11);
                if (type < 2) head_norm_rope(v, gain, true, row & (SEQ - 1), fq, cosT, sinT);
                bf16_t* rp = dst + (size_t)row * 3072 + slot * 64 + 8 * fq;
                *(u32x4*)(rp) = pack8(v[0]); *(u32x4*)(rp + 32) = pack8(v[1]); }
    }
};
struct EpiKV {
    bf16_t* dst; const float *kgain3, *cosT, *sinT; const float* ssp; const float* bias;
    DI void operator()(const AccT& acc, const Unit& u, int wr, int wc, int fr, int fq) const {
        const int slot = 4 * u.pn + wc, branch = slot >> 2, kv = (slot >> 1) & 1, kvh = slot & 1; const int row0 = u.pm * 256 + wr * 64 + fr;
        const bool nr = (kv == 0) && (branch > 0);
        const float* bp = bias + (size_t)((u.pm * 256) >> 13) * 768 + slot * 64 + 8 * fq; LOAD_B4(bp); LOAD_RI(ri, ssp, row0);
#pragma unroll
        for (int ai = 0; ai < 2; ++ai)
#pragma unroll
            for (int m = 0; m < 4; ++m) { __builtin_amdgcn_sched_barrier(0); const int row = row0 + ai * 128 + m * 16; float v[2][8]; ACC16B(v, acc, ai, m, ri[ai * 4 + m], b00, b01, b10, b11);
                if (nr) head_norm_rope(v, kgain3 + branch * 64, true, row & (SEQ - 1), fq, cosT, sinT);
                bf16_t* rp = dst + ((size_t)((((branch * 2 + kv) * 4 + (row >> 13)) * 2 + kvh)) * SEQ + (row & (SEQ - 1))) * 64 + 8 * fq;
                *(u32x4*)(rp) = pack8(v[0]); *(u32x4*)(rp + 32) = pack8(v[1]); }
    }
};
struct EpiCmp1 {
    bf16_t* hc; const float* bias;
    DI void operator()(const AccT& acc, const Unit& u, int wr, int wc, int fr, int fq) const {
        const int row0 = u.pm * 256 + wr * 64 + fr, col0 = wc * 32 + 8 * fq;
        const f32x4 b0 = *(const f32x4*)(bias + col0), b1 = *(const f32x4*)(bias + col0 + 4);
#pragma unroll
        for (int ai = 0; ai < 2; ++ai)
#pragma unroll
            for (int m = 0; m < 4; ++m) { __builtin_amdgcn_sched_barrier(0); const int row = row0 + ai * 128 + m * 16; float o[8];
#pragma unroll
                for (int n = 0; n < 2; ++n)
#pragma unroll
                    for (int j = 0; j < 4; ++j) { const float a = acc[ai][0][m][n][j] + (n ? b1[j] : b0[j]); o[4 * n + j] = a / (1.0f + __expf(-a)); }
                *(u32x4*)(hc + (size_t)row * 256 + col0) = pack8(o);
                *(u32x4*)(hc + (size_t)row * 256 + 128 + col0) = (u32x4){0u, 0u, 0u, 0u}; }
    }
};
template <bool NORM> struct EpiCmp2 {
    bf16_t* dst; const float* gain;
    DI void operator()(const AccT& acc, const Unit& u, int wr, int wc, int fr, int fq) const {
        if (wc != 0) return;
        const int row0 = u.pm * 256 + wr * 64 + fr;
#pragma unroll
        for (int ai = 0; ai < 2; ++ai)
#pragma unroll
            for (int m = 0; m < 4; ++m) { __builtin_amdgcn_sched_barrier(0); const int row = row0 + ai * 128 + m * 16; float v[2][8]; ACC16(v, acc, ai, m);
                if (NORM) head_norm_rope(v, gain, false, 0, fq, nullptr, nullptr);
                bf16_t* rp = dst + (size_t)row * 64 + 8 * fq;
                *(u32x4*)(rp) = pack8(v[0]); *(u32x4*)(rp + 32) = pack8(v[1]); }
    }
};
struct EpiQG {
    bf16_t *qn, *qr; float* gates; const float *qgain, *cosT, *sinT; const float* ssp; const float* bias;
    DI void operator()(const AccT& acc, const Unit& u, int wr, int wc, int fr, int fq) const {
        const int row0 = u.pm * 256 + wr * 64 + fr;
        if (u.pn < 4) {
            const int slot = 4 * u.pn + wc;
            const float* bp = bias + (size_t)((u.pm * 256) >> 13) * 1280 + slot * 64 + 8 * fq;
#pragma unroll
            for (int ai = 0; ai < 2; ++ai)
#pragma unroll
                for (int m = 0; m < 4; ++m) { __builtin_amdgcn_sched_barrier(0); const int row = row0 + ai * 128 + m * 16; float v[2][8]; const float rir = row_rinv(ssp, row); { LOAD_B4(bp); ACC16B(v, acc, ai, m, rir, b00, b01, b10, b11); }
                    head_norm_rope(v, qgain, false, 0, fq, nullptr, nullptr);
                    bf16_t* rp = qn + (size_t)row * DM + slot * 64 + 8 * fq;
                    *(u32x4*)(rp) = pack8(v[0]); *(u32x4*)(rp + 32) = pack8(v[1]);
                    const int pos = row & (SEQ - 1);
                    const f32x4 c0 = *(const f32x4*)(cosT + pos * 32 + 8 * fq), c1 = *(const f32x4*)(cosT + pos * 32 + 8 * fq + 4);
                    const f32x4 s0 = *(const f32x4*)(sinT + pos * 32 + 8 * fq), s1 = *(const f32x4*)(sinT + pos * 32 + 8 * fq + 4);
#pragma unroll
                    for (int e = 0; e < 8; ++e) { const float c = e < 4 ? c0[e & 3] : c1[e & 3], s = e < 4 ? s0[e & 3] : s1[e & 3];
                        const float x1 = v[0][e], x2 = v[1][e]; v[0][e] = x1 * c - x2 * s; v[1][e] = x1 * s + x2 * c; }
                    bf16_t* rq = qr + (size_t)row * DM + slot * 64 + 8 * fq;
                    *(u32x4*)(rq) = pack8(v[0]); *(u32x4*)(rq + 32) = pack8(v[1]); }
        } else {
            const int col0 = wc * 32 + 8 * fq;
            if (col0 < 48) {
                const float* bpg = bias + (size_t)((u.pm * 256) >> 13) * 1280 + 1024 + col0; const f32x4 bg0 = *(const f32x4*)(bpg), bg1 = *(const f32x4*)(bpg + 4);
#pragma unroll
                for (int ai = 0; ai < 2; ++ai)
#pragma unroll
                    for (int m = 0; m < 4; ++m) { __builtin_amdgcn_sched_barrier(0); const int row = row0 + ai * 128 + m * 16; const float rir = row_rinv(ssp, row);
#pragma unroll
                        for (int n = 0; n < 2; ++n) { f32x4 r; const f32x4 bb = n ? bg1 : bg0;
#pragma unroll
                            for (int j = 0; j < 4; ++j) r[j] = __builtin_amdgcn_rcpf(1.0f + __expf(-fmaf(acc[ai][0][m][n][j], rir, bb[j])));
                            *(f32x4*)(gates + (size_t)row * 48 + col0 + 4 * n) = r; } }
            }
        }
    }
};

DI int perm_col(int perm, int c) {
    const int hp = 64 * (4 * (c >> 8) + ((c & 127) >> 5)) + 32 * ((c & 255) >> 7) + (c & 31);
    if (perm == 0) return c;
    if (perm == 1) return hp;
    if (perm == 2) return ((c & 255) >> 7) * DFF + 128 * (c >> 8) + (c & 127);
    return c < 1024 ? hp : c;
}
DI void phase_prep(KP p, LAS unsigned char* lds, const int tid, const int bid, const int nblk) {
    float* modP = (float*)(p->ws + WS_MODP);
    {
        LAS float* ca = (LAS float*)lds;
        for (int i = tid; i < NB * DM; i += 512) { const float v = p->c[i]; ca[i] = v / (1.0f + __expf(-v)); }
        __syncthreads();
        for (int item = bid * 512 + tid; item < 16 * (MODW / 4); item += nblk * 512) {
            const int ks = item / (MODW / 4), col = (item % (MODW / 4)) * 4;
            const float* W; int ldw, cc;
            if (col < 18432) { const int l = col / 9216; cc = col % 9216; W = p->w_ada + (size_t)l * DM * 9216; ldw = 9216; } else { cc = col - 18432; W = p->w_ada_kv; ldw = 2048; }
            f32x4 a0 = {0.f, 0.f, 0.f, 0.f}, a1 = a0, a2 = a0, a3 = a0;
            for (int k = ks * 64; k < ks * 64 + 64; ++k) { const f32x4 w = *(const f32x4*)(W + (size_t)k * ldw + cc);
                a0 += ca[k] * w; a1 += ca[DM + k] * w; a2 += ca[2 * DM + k] * w; a3 += ca[3 * DM + k] * w; }
            *(f32x4*)(modP + (size_t)(ks * 4 + 0) * MODW + col) = a0; *(f32x4*)(modP + (size_t)(ks * 4 + 1) * MODW + col) = a1;
            *(f32x4*)(modP + (size_t)(ks * 4 + 2) * MODW + col) = a2; *(f32x4*)(modP + (size_t)(ks * 4 + 3) * MODW + col) = a3;
        }
        __syncthreads();
    }
    {
        float* cT = (float*)(p->ws + WS_ROPEC); float* sT = (float*)(p->ws + WS_ROPES);
        for (int idx = bid * 512 + tid; idx < SEQ * 32; idx += nblk * 512) {
            const int pos = idx >> 5, i = idx & 31;
            const float inv = exp2f(-(float)i * 0.41524101186092029f);
            const float ang = (float)pos * inv;
            const float n = rintf(ang * 0.63661977236758134f);
            float r = fmaf(-n, 1.57079637050628662109375f, ang); r = fmaf(-n, -4.37113900018624283e-8f, r);
            const float r2 = r * r;
            float sp = 2.7557319e-6f; sp = sp * r2 - 1.9841270e-4f; sp = sp * r2 + 8.3333333e-3f; sp = sp * r2 - 1.6666667e-1f;
            const float sn = r + r * r2 * sp;
            float cp = -2.7557319e-7f; cp = cp * r2 + 2.4801587e-5f; cp = cp * r2 - 1.3888889e-3f; cp = cp * r2 + 4.1666667e-2f; cp = cp * r2 - 0.5f;
            const float cs1 = 1.0f + r2 * cp;
            const int q = ((int)n) & 3;
            const float cs = (q == 0) ? cs1 : (q == 1) ? -sn : (q == 2) ? -cs1 : sn;
            const float ss = (q == 0) ? sn : (q == 1) ? cs1 : (q == 2) ? -sn : -cs1;
            cT[idx] = cs; sT[idx] = ss;
        }
    }
    {
        LAS float* red = (LAS float*)lds;
        float* bias1 = (float*)(p->ws + WS_BIAS1);
        for (int o = bid; o < 256; o += nblk) {
            const int which = o >> 7, n = o & 127; float s = 0.f;
            for (int j = 0; j < 4; ++j) { const int k = tid * 4 + j; s += p->cmp_pos[which * 2048 + k] * p->phi_w1[(size_t)which * 2048 * 128 + (size_t)k * 128 + n]; }
            s = wave_sum(s);
            __syncthreads();
            if ((tid & 63) == 0) red[tid >> 6] = s;
            __syncthreads();
            if (tid == 0) { float t = 0.f; for (int w = 0; w < 8; ++w) t += red[w]; bias1[o] = t; }
        }
        __syncthreads();
    }
    {
        LAS float* tile = (LAS float*)lds;
        for (int jn = 0; jn < NJOBS; ++jn) {
            Job jb; jb.src = p->jobs[jn].src; jb.dst = p->jobs[jn].dst; jb.nsrc = p->jobs[jn].nsrc; jb.ksrc = p->jobs[jn].ksrc; jb.kdst = p->jobs[jn].kdst; jb.ndst = p->jobs[jn].ndst; jb.perm = p->jobs[jn].perm;
            const int nkt = jb.kdst >> 6, nct = jb.ndst >> 7, ntile = nkt * nct;
            for (int t = bid; t < ntile; t += nblk) {
                const int c0 = (t / nkt) << 7, k0 = (t % nkt) << 6;
                { const int tx = tid & 31, ty = tid >> 5; const int L = perm_col(jb.perm, c0 + 4 * tx); const bool okc = L < jb.nsrc;
                    f32x4 v[4];
#pragma unroll
                    for (int i = 0; i < 4; ++i) { const int k = k0 + ty + 16 * i; v[i] = (f32x4){0.f, 0.f, 0.f, 0.f}; if (okc && k < jb.ksrc) v[i] = *(const f32x4*)(jb.src + (size_t)k * jb.nsrc + L); }
#pragma unroll
                    for (int i = 0; i < 4; ++i) { LAS float* tp = tile + (ty + 16 * i) * 129 + 4 * tx; tp[0] = v[i][0]; tp[1] = v[i][1]; tp[2] = v[i][2]; tp[3] = v[i][3]; } }
                __syncthreads();
                { const int cl = tid >> 2, kq = tid & 3; float o[16];
#pragma unroll
                    for (int i = 0; i < 16; ++i) o[i] = tile[(kq * 16 + i) * 129 + cl];
                    bf16_t* dp = jb.dst + (size_t)(c0 + cl) * jb.kdst + k0 + kq * 16;
                    *(u32x4*)(dp) = pack8(o); *(u32x4*)(dp + 8) = pack8(o + 8); }
                __syncthreads();
            }
        }
    }
}
DI void phase_modfinal(KP p, const int tid, const int bid, const int nblk) {
    const float* modP = (const float*)(p->ws + WS_MODP); float* modF = (float*)(p->ws + WS_MODF);
    for (int idx = bid * 512 + tid; idx < NB * MODW; idx += nblk * 512) {
        const int b = idx / MODW, col = idx % MODW;
        float s = col < 18432 ? p->b_ada[col] : p->b_ada_kv[col - 18432];
        for (int ks = 0; ks < 16; ++ks) s += modP[(size_t)(ks * 4 + b) * MODW + col];
        modF[idx] = s;
    }
}
DI void phase_bias(KP p, LAS unsigned char* lds, const int tid, const int bid, const int nblk) {
    const float* modF = (const float*)(p->ws + WS_MODF);
    float* gsv = (float*)(p->ws + WS_GS); float* bv = (float*)(p->ws + WS_BV);
    for (int idx = bid * 512 + tid; idx < 7 * 4 * DM; idx += nblk * 512) {
        const int s = idx >> 12, b = (idx >> 10) & 3, d = idx & 1023; const int t = s < 4 ? s : s - 1;
        const int off = s == 4 ? 18432 : t * 3072; const float g = s == 4 ? p->kv_norm_g[d] : p->norm_g[t * DM + d];
        gsv[idx] = g * (1.0f + modF[(size_t)b * MODW + off + 1024 + d]);
    }
    { float* ssz = (float*)(p->ws + WS_SSPA) + NTOK; for (int i = bid * 512 + tid; i < 6 * NTOK; i += nblk * 512) ssz[i] = 0.f; }
    LAS float* sh = (LAS float*)lds; LAS float* red = (LAS float*)(lds + 16384);
    for (int item = bid; item < 525; item += nblk) {
        const float* W; int N, s, bvoff, nout, i0;
        if (item < 352) { const int c = item / 88; i0 = c * 88; W = p->ffn_w_in + (size_t)c * DM * 5632; N = 5632; nout = 5632; bvoff = c * BV_FFN; s = c == 0 ? 0 : (c == 1 ? 2 : (c == 2 ? 3 : 6)); }
        else if (item < 496) { i0 = 352; W = p->a_w_qkv; N = 9216; nout = 9216; bvoff = BV_QKV; s = 1; }
        else if (item < 508) { i0 = 496; W = p->w_kv; N = 768; nout = 768; bvoff = BV_KV; s = 4; }
        else { i0 = 508; W = p->b_w_qg; N = 1072; nout = 1280; bvoff = BV_QG; s = 5; }
        const int off = s == 4 ? 18432 : (s < 4 ? s : s - 1) * 3072; const int col0 = (item - i0) * 64;
        for (int i = tid; i < 4 * DM; i += 512) sh[i] = modF[(size_t)(i >> 10) * MODW + off + (i & 1023)];
        __syncthreads();
        const int kc = tid >> 4, cg4 = tid & 15, col = col0 + 4 * cg4;
        f32x4 a0 = {0.f, 0.f, 0.f, 0.f}, a1 = a0, a2 = a0, a3 = a0;
        if (col < N) for (int k = kc * 32; k < kc * 32 + 32; ++k) { const f32x4 w = *(const f32x4*)(W + (size_t)k * N + col); a0 += sh[k] * w; a1 += sh[DM + k] * w; a2 += sh[2 * DM + k] * w; a3 += sh[3 * DM + k] * w; }
#pragma unroll
        for (int j = 0; j < 4; ++j) { red[(kc * 4 + 0) * 64 + cg4 * 4 + j] = a0[j]; red[(kc * 4 + 1) * 64 + cg4 * 4 + j] = a1[j]; red[(kc * 4 + 2) * 64 + cg4 * 4 + j] = a2[j]; red[(kc * 4 + 3) * 64 + cg4 * 4 + j] = a3[j]; }
        __syncthreads();
        if (tid < 256) { const int b = tid >> 6, cc = tid & 63; float t = 0.f; for (int q = 0; q < 32; ++q) t += red[(q * 4 + b) * 64 + cc];
            if (col0 + cc < N) bv[bvoff + b * nout + col0 + cc] = t; }
        __syncthreads();
    }
    {
        const int lane = tid & 63, wid = tid >> 6; bf16_t* out = (bf16_t*)(p->out); float* ssp = (float*)(p->ws + WS_SSPA); const float* x = p->x; const float* g1 = p->norm_g;
        for (int row = bid * 8 + wid; row < NTOK; row += nblk * 8) {
            const int b = row >> 13; const f32x4* hr = (const f32x4*)(x + (size_t)row * DM);
            f32x4 v[4]; float ss = 0.f;
#pragma unroll
            for (int i = 0; i < 4; ++i) { v[i] = hr[lane + 64 * i]; ss += v[i][0] * v[i][0] + v[i][1] * v[i][1] + v[i][2] * v[i][2] + v[i][3] * v[i][3]; }
            ss = wave_sum(ss);
#pragma unroll
            for (int i = 0; i < 4; ++i) { const int col = 4 * (lane + 64 * i);
                const f32x4 g = *(const f32x4*)(g1 + col), sc = *(const f32x4*)(modF + (size_t)b * MODW + 1024 + col);
                float y[4];
#pragma unroll
                for (int j = 0; j < 4; ++j) y[j] = v[i][j] * (g[j] * (1.0f + sc[j]));
                *(u32x2*)(out + (size_t)row * DM + col) = (u32x2){pk2(y[0], y[1]), pk2(y[2], y[3])}; }
            if (lane == 0) ssp[row] = ss;
        }
    }
}
DI void phase_normmod(const float* h, const float* g1, const float* mod1, bf16_t* out1, const float* g2, const float* mod2, bf16_t* out2, const int tid, const int bid, const int nblk) {
    const int lane = tid & 63, wid = tid >> 6;
    for (int row = bid * 8 + wid; row < NTOK; row += nblk * 8) {
        const int b = row >> 13; const f32x4* hr = (const f32x4*)(h + (size_t)row * DM);
        f32x4 v[4]; float ss = 0.f;
#pragma unroll
        for (int i = 0; i < 4; ++i) { v[i] = hr[lane + 64 * i]; ss += v[i][0] * v[i][0] + v[i][1] * v[i][1] + v[i][2] * v[i][2] + v[i][3] * v[i][3]; }
        ss = wave_sum(ss);
        const float rinv = rsqrtf(ss * (1.0f / DM) + EPSN);
#pragma unroll
        for (int i = 0; i < 4; ++i) { const int col = 4 * (lane + 64 * i);
            { const f32x4 g = *(const f32x4*)(g1 + col), sh = *(const f32x4*)(mod1 + (size_t)b * MODW + col), sc = *(const f32x4*)(mod1 + (size_t)b * MODW + 1024 + col);
              float y[4];
#pragma unroll
              for (int j = 0; j < 4; ++j) y[j] = v[i][j] * rinv * g[j] * (1.0f + sc[j]) + sh[j];
              *(u32x2*)(out1 + (size_t)row * DM + col) = (u32x2){pk2(y[0], y[1]), pk2(y[2], y[3])}; }
            if (out2) { const f32x4 g = *(const f32x4*)(g2 + col), sh = *(const f32x4*)(mod2 + (size_t)b * MODW + col), sc = *(const f32x4*)(mod2 + (size_t)b * MODW + 1024 + col);
              float y[4];
#pragma unroll
              for (int j = 0; j < 4; ++j) y[j] = v[i][j] * rinv * g[j] * (1.0f + sc[j]) + sh[j];
              *(u32x2*)(out2 + (size_t)row * DM + col) = (u32x2){pk2(y[0], y[1]), pk2(y[2], y[3])}; }
        }
    }
}

constexpr int ROWB = 144;
constexpr int ROWBV = 192;
#define MFMA32(a, b, c) __builtin_amdgcn_mfma_f32_32x32x16_bf16((a), (b), (c), 0, 0, 0)
DI f32x16 qk_tile(const LAS unsigned char* Kt, const bf16x8 (&Qb)[4], int r, int h) {
    f32x16 st;
#pragma unroll
    for (int i = 0; i < 16; ++i) st[i] = 0.f;
#pragma unroll
    for (int ks = 0; ks < 4; ++ks) { const bf16x8 kf = *(const LAS bf16x8*)(Kt + r * ROWB + (16 * ks + 8 * h) * 2); st = MFMA32(kf, Qb[ks], st); }
    return st;
}
template <int RB = 144>
DI void pv_tile(const LAS unsigned char* Vt, const float (&pv)[16], f32x16 (&o)[2], int lane) {
    const int h = lane >> 5, dg = (lane >> 4) & 1, i16 = lane & 15;
    const LAS unsigned char* vb = Vt + (4 * h + (i16 >> 2)) * RB + (16 * dg + 4 * (i16 & 3)) * 2;
#pragma unroll
    for (int s = 0; s < 2; ++s) {
        u32x4 pw; pw.x = pk2(pv[8 * s], pv[8 * s + 1]); pw.y = pk2(pv[8 * s + 2], pv[8 * s + 3]); pw.z = pk2(pv[8 * s + 4], pv[8 * s + 5]); pw.w = pk2(pv[8 * s + 6], pv[8 * s + 7]);
        const bf16x8 pf = __builtin_bit_cast(bf16x8, pw);
#pragma unroll
        for (int mt = 0; mt < 2; ++mt) {
            const s16x4 lo = __builtin_amdgcn_ds_read_tr16_b64_v4i16((LAS s16x4*)(vb + (16 * s) * RB + mt * 64));
            const s16x4 hi = __builtin_amdgcn_ds_read_tr16_b64_v4i16((LAS s16x4*)(vb + (16 * s + 8) * RB + mt * 64));
            const bf16x8 vf = __builtin_shufflevector(lo, hi, 0, 1, 2, 3, 4, 5, 6, 7);
            o[mt] = MFMA32(vf, pf, o[mt]);
        }
    }
}
template <bool MASKED>
DI void softmax_fx(const f32x16& st, unsigned vmask, float bias, float& lsum, float (&pv)[16]) {
    float ps = 0.f;
#pragma unroll
    for (int i = 0; i < 16; ++i) { float s = fmaf(st[i], SC2, bias); if (MASKED) s = ((vmask >> i) & 1u) ? s : -1e30f; const float pe = __builtin_amdgcn_exp2f(s); pv[i] = pe; ps += pe; }
    lsum += ps;
}
DI float softmax_shift(const float* gq, const float* gk, int lane) {
    float a = fabsf(gq[lane]), b = fabsf(gk[lane]);
    for (int o = 32; o >= 1; o >>= 1) { a = fmaxf(a, __shfl_xor(a, o, 64)); b = fmaxf(b, __shfl_xor(b, o, 64)); }
    return fmaxf(0.f, 64.0f * SC2 * a * b - 60.0f);
}

DI void qk_pair(const LAS unsigned char* Kt, const bf16x8 (&Qb)[4], int r, int h, f32x16& s0, f32x16& s1) {
#pragma unroll
    for (int i = 0; i < 16; ++i) { s0[i] = 0.f; s1[i] = 0.f; }
#pragma unroll
    for (int ks = 0; ks < 4; ++ks) { const bf16x8 k0 = *(const LAS bf16x8*)(Kt + r * ROWB + (16 * ks + 8 * h) * 2), k1 = *(const LAS bf16x8*)(Kt + (32 + r) * ROWB + (16 * ks + 8 * h) * 2);
        s0 = MFMA32(k0, Qb[ks], s0); s1 = MFMA32(k1, Qb[ks], s1); }
}
DI void pv_pair(const LAS unsigned char* Vt, const float (&p0)[16], const float (&p1)[16], f32x16 (&o)[2], int lane) {
    pv_tile<ROWBV>(Vt, p0, o, lane); pv_tile<ROWBV>(Vt + 32 * ROWBV, p1, o, lane);
}
DI void phase_dilated(KP p, LAS unsigned char* lds, int g, const int tid, const int bid, const int nblk) {
    const int R = g == 0 ? 1 : (g == 1 ? 4 : 16), nqb = (SEQ / R) / 256, nunits = NB * R * 16 * nqb;
    const bf16_t* qkv = (const bf16_t*)(p->ws + WS_QKVG); bf16_t* oacc = (bf16_t*)(p->ws + WS_OACC); float* lse = (float*)(p->ws + WS_LSE);
    const int lane = tid & 63, wid = tid >> 6, r = lane & 31, h = lane >> 5;
    LAS unsigned char* Ks = lds; LAS unsigned char* Vs = lds + 384 * ROWB; LAS unsigned char* Qs = lds + 768 * ROWB;
    const float shift = softmax_shift(p->a_q_gain + g * 64, p->a_k_gain + g * 64, lane);
    u32x4 rg[16];
    auto load_unit = [&](int un) {
        const int qb_ = un % nqb; int tmp_ = un / nqb; const int hd_ = tmp_ % 16; tmp_ /= 16; const int res_ = tmp_ % R, b_ = tmp_ / R;
        const int Q0_ = qb_ * 256, kbase_ = Q0_ - 128;
#pragma unroll
        for (int j = 0; j < 16; ++j) { const int idx = tid + 512 * j;
            const int row = idx >> 3, ch = idx & 7; const int which = row < 384 ? 0 : (row < 768 ? 1 : 2);
            const int lr = row - (which == 0 ? 0 : (which == 1 ? 384 : 768));
            const int mm = which < 2 ? kbase_ + lr : Q0_ + lr;
            u32x4 val = {0u, 0u, 0u, 0u};
            if (mm >= 0) { const size_t tok = (size_t)b_ * SEQ + (size_t)mm * R + res_; const int col = (which == 0 ? 1024 : (which == 1 ? 2048 : 0)) + hd_ * 64 + ch * 8;
                val = *(const u32x4*)(qkv + tok * 3072 + col); }
            rg[j] = val; }
    };
    const bool swz = ((nblk & 7) == 0) && (nunits % nblk == 0);
    const int nit = (nunits + nblk - 1) / nblk;
    auto unit_of = [&](int i) { return swz ? (bid & 7) * (nunits >> 3) + i * (nblk >> 3) + (bid >> 3) : i * nblk + bid; };
    if (unit_of(0) < nunits) load_unit(unit_of(0));
    for (int it = 0; it < nit; ++it) {
        const int unit = unit_of(it); if (unit >= nunits) break;
        const int qb = unit % nqb; int tmp = unit / nqb; const int hd = tmp % 16; tmp /= 16; const int res = tmp % R, b = tmp / R;
        const int Q0 = qb * 256, kbase = Q0 - 128;
#pragma unroll
        for (int j = 0; j < 16; ++j) { const int idx = tid + 512 * j; *(LAS u32x4*)(lds + (idx >> 3) * ROWB + (idx & 7) * 16) = rg[j]; }
        __syncthreads();
        if (it + 1 < nit && unit_of(it + 1) < nunits) load_unit(unit_of(it + 1));
        bf16x8 Qb[4];
#pragma unroll
        for (int ks = 0; ks < 4; ++ks) Qb[ks] = *(const LAS bf16x8*)(Qs + (32 * wid + r) * ROWB + (16 * ks + 8 * h) * 2);
        float lsum = 0.f; f32x16 o[2];
#pragma unroll
        for (int i = 0; i < 16; ++i) { o[0][i] = 0.f; o[1][i] = 0.f; }
        const int qm = Q0 + 32 * wid + r;
        for (int tt = 0; tt < 5; ++tt) {
            const int jt = wid + tt; const int k0 = kbase + 32 * jt;
            if (k0 + 31 < 0) continue;
            const f32x16 st = qk_tile(Ks + jt * 32 * ROWB, Qb, r, h);
            float pv[16];
            if (tt == 0 || tt == 4) {
                unsigned vmask = 0u;
#pragma unroll
                for (int i = 0; i < 16; ++i) { const int km = k0 + crow(i, h); const bool ok = (km <= qm) && (qm - km <= 128); vmask |= ok ? (1u << i) : 0u; }
                softmax_fx<true>(st, vmask, -shift, lsum, pv);
            } else softmax_fx<false>(st, 0u, -shift, lsum, pv);
            pv_tile(Vs + jt * 32 * ROWB, pv, o, lane);
        }
        const float ltot = lsum + __shfl_xor(lsum, 32, 64);
        const float inv = 1.0f / ltot; const float lse_cur = (shift + log2f(ltot)) * LN2;
        const size_t tok = (size_t)b * SEQ + (size_t)qm * R + res;
        float wp = 0.f, wc2 = 1.f, lse_new = lse_cur;
        if (g > 0) { const float lp = lse[tok * 16 + hd]; const float mxl = fmaxf(lp, lse_cur); lse_new = mxl + logf(__expf(lp - mxl) + __expf(lse_cur - mxl)); wp = __expf(lp - lse_new); wc2 = __expf(lse_cur - lse_new); }
        bf16_t* op = oacc + tok * DM + hd * 64;
#pragma unroll
        for (int mt = 0; mt < 2; ++mt)
#pragma unroll
            for (int ig = 0; ig < 4; ++ig) { const int d0 = 32 * mt + 8 * ig + 4 * h;
                float v0 = o[mt][4 * ig] * inv * wc2, v1 = o[mt][4 * ig + 1] * inv * wc2, v2 = o[mt][4 * ig + 2] * inv * wc2, v3 = o[mt][4 * ig + 3] * inv * wc2;
                if (g > 0) { const u32x2 pr = *(const u32x2*)(op + d0); v0 += wp * bf_lo(pr.x); v1 += wp * bf_hi(pr.x); v2 += wp * bf_lo(pr.y); v3 += wp * bf_hi(pr.y); }
                *(u32x2*)(op + d0) = (u32x2){pk2(v0, v1), pk2(v2, v3)}; }
        if (h == 0) lse[tok * 16 + hd] = lse_new;
        __syncthreads();
    }
}

constexpr int NSA_KVBUF = 128 * ROWB + 128 * ROWBV;
constexpr int NSA_PSUM = 2 * NSA_KVBUF;
constexpr int NSA_IMP = NSA_PSUM + 8 * 4 * 512 * 4;
constexpr int NSA_SEL = NSA_IMP + 8 * 128 * 4;
template <int CH, bool WHOLE = false, class F>
DI void stream_keys(const int tid, const bf16_t* Kg, const bf16_t* Vg, int key_lo, int nch, LAS unsigned char* lds, F&& fn) {
    static_assert(CH == 128, "ring image is laid out for 128-key chunks");
    constexpr int BUF = NSA_KVBUF, KBLK = 128 * 9 / 64, NBLK = KBLK + 128 * 12 / 64, NIT = (NBLK + 7) / 8;
    const int wid = __builtin_amdgcn_readfirstlane(tid >> 6), lane = tid & 63;
    auto issue = [&](int c, LAS unsigned char* buf) {
#pragma unroll
        for (int i = 0; i < NIT; ++i) { const int blk = i * 8 + wid;
            if (blk < NBLK) { const int L = blk * 64 + lane; const bool isv = blk >= KBLK; const int Lr = L - (isv ? 128 * 9 : 0); const int ppr = isv ? 12 : 9; const int row = Lr / ppr, ch = Lr - row * ppr;
                const bf16_t* srcp = (isv ? Vg : Kg) + (size_t)(key_lo + c * CH + row) * 64 + (ch >= 8 ? 0 : ch) * 8;
                __builtin_amdgcn_global_load_lds((const unsigned*)srcp, (LAS unsigned*)(buf + blk * 1024), 16, 0, 0); } }
    };
    issue(0, lds);
    for (int c = 0; c < nch; ++c) {
        LAS unsigned char* buf = lds + (c & 1) * BUF;
        asm volatile("s_waitcnt vmcnt(0)" ::: "memory");
        __syncthreads();
        if (c + 1 < nch) issue(c + 1, lds + ((c + 1) & 1) * BUF);
        if (WHOLE) fn(key_lo + c * CH, buf, buf + CH * ROWB);
        else {
#pragma unroll 1
        for (int t2 = 0; t2 < CH / 64; ++t2) fn(key_lo + c * CH + t2 * 64, buf + t2 * 64 * ROWB, buf + CH * ROWB + t2 * 64 * ROWBV); }
    }
    __syncthreads();
}
DI void load_q(bf16x8 (&Qb)[4], const bf16_t* q, size_t tok, int head, int h) {
#pragma unroll
    for (int ks = 0; ks < 4; ++ks) Qb[ks] = *(const bf16x8*)(q + tok * DM + head * 64 + 16 * ks + 8 * h);
}
DI void phase_nsa(KP p, LAS unsigned char* lds, const int tid, const int bid, const int nblk) {
    const bf16_t* kvb = (const bf16_t*)(p->ws + WS_KV); const bf16_t* cmpb = (const bf16_t*)(p->ws + WS_CMP);
    const bf16_t* qn = (const bf16_t*)(p->ws + WS_QN); const bf16_t* qr = (const bf16_t*)(p->ws + WS_QR);
    const float* gates = (const float*)(p->ws + WS_GATES); bf16_t* outp = (bf16_t*)(p->ws + WS_UKV);
    const int lane = tid & 63, wid = tid >> 6, r = lane & 31, h = lane >> 5, ql = r >> 3, hl = r & 7;
    LAS float* psw = (LAS float*)(lds + NSA_PSUM + wid * 4 * 512 * 4);
    LAS float* impw = (LAS float*)(lds + NSA_IMP + wid * 128 * 4);
    LAS unsigned long long* selw = (LAS unsigned long long*)(lds + NSA_SEL + wid * 64);
    const int nunits = NB * 2 * (SEQ / 32);
    const float shc = __int_as_float(__builtin_amdgcn_readfirstlane(__float_as_int(softmax_shift(p->b_q_gain, p->kv_k_gain, lane))));
    const float shs = __int_as_float(__builtin_amdgcn_readfirstlane(__float_as_int(softmax_shift(p->b_q_gain, p->kv_k_gain + 64, lane))));
    const float shw = __int_as_float(__builtin_amdgcn_readfirstlane(__float_as_int(softmax_shift(p->b_q_gain, p->kv_k_gain + 128, lane))));
    for (int it = 0; it * nblk < nunits; ++it) {
        const int bi = (it & 1) ? (nblk - 1 - bid) : bid;
        const int unit = it * nblk + bi;
        if (unit >= nunits) continue;
        const int qb = unit >> 3, b = (unit >> 1) & 3, kvh = unit & 1;
        const int t0 = qb * 32, tw = t0 + 4 * wid, t = tw + ql;
        const size_t tok = (size_t)b * SEQ + t; const int head = kvh * 8 + hl;
        bf16x8 Qb[4];
        {
            load_q(Qb, qn, tok, head, h);
            const bf16_t* Kc = cmpb + (size_t)(b * 2 + kvh) * 512 * 64; const bf16_t* Vc = cmpb + (size_t)4096 * 64 + (size_t)(b * 2 + kvh) * 512 * 64;
            const int ncv = t0 / 16 + 1 > 511 ? 511 : t0 / 16 + 1; const int nch = (ncv + 127) / 128;
            for (int i = lane; i < 4 * 512; i += 64) psw[i] = 0.f;
            float lsum = 0.f;
            stream_keys<128>(tid, Kc, Vc, 0, nch, lds, [&](int k0, const LAS unsigned char* Kt, const LAS unsigned char* Vt) {
                if (k0 * 16 + 31 > tw + 3) return;
                f32x16 s0, s1; qk_pair(Kt, Qb, r, h, s0, s1);
                unsigned vm0 = 0u, vm1 = 0u;
#pragma unroll
                for (int i = 0; i < 16; ++i) { const int c = k0 + crow(i, h); vm0 |= (c * 16 + 31 <= t) ? (1u << i) : 0u; vm1 |= ((c + 32) * 16 + 31 <= t) ? (1u << i) : 0u; }
                float pv[16];
                softmax_fx<true>(s0, vm0, -shc, lsum, pv); softmax_fx<true>(s1, vm1, -shc, lsum, pv);
            });
            const float ltot = lsum + __shfl_xor(lsum, 32, 64);
            const float linv = 1.0f / fmaxf(ltot, 1e-30f);
            f32x16 o[2];
#pragma unroll
            for (int i = 0; i < 16; ++i) { o[0][i] = 0.f; o[1][i] = 0.f; }
            stream_keys<128>(tid, Kc, Vc, 0, nch, lds, [&](int k0, const LAS unsigned char* Kt, const LAS unsigned char* Vt) {
                if (k0 * 16 + 31 > tw + 3) return;
                f32x16 s0, s1; qk_pair(Kt, Qb, r, h, s0, s1);
                float p0[16], p1[16];
#pragma unroll
                for (int i = 0; i < 16; ++i) { const int c = k0 + crow(i, h);
                    p0[i] = (c * 16 + 31 <= t) ? __builtin_amdgcn_exp2f(fmaf(s0[i], SC2, -shc)) * linv : 0.f;
                    p1[i] = ((c + 32) * 16 + 31 <= t) ? __builtin_amdgcn_exp2f(fmaf(s1[i], SC2, -shc)) * linv : 0.f; }
#pragma unroll
                for (int i = 0; i < 16; ++i) { const float a = sum8(p0[i]), b = sum8(p1[i]);
                    if (hl == 0) { psw[ql * 512 + k0 + crow(i, h)] = a; psw[ql * 512 + k0 + 32 + crow(i, h)] = b; } }
                pv_pair(Vt, p0, p1, o, lane);
            });
            const float g0 = gates[tok * 48 + head];
            LAS float* stash = (LAS float*)(lds + wid * 8192);
#pragma unroll
            for (int i = 0; i < 16; ++i) { stash[i * 64 + lane] = g0 * o[0][i]; stash[(16 + i) * 64 + lane] = g0 * o[1][i]; }
        }
        __builtin_amdgcn_wave_barrier();
        unsigned long long sello = 0ull, selhi = 0ull;
        for (int q4 = 0; q4 < 4; ++q4) {
            const int tq = tw + q4, jtq = tq >> 6;
            unsigned key[2]; bool cand[2], fsel[2];
#pragma unroll
            for (int e = 0; e < 2; ++e) { const int jj = lane + 64 * e, c4 = 4 * jj; const LAS float* P = psw + q4 * 512;
                float im = (c4 > 0) ? P[c4 - 1] : 0.f; im = im + 2.0f * P[c4]; im = im + 2.0f * P[c4 + 1]; im = im + 2.0f * P[c4 + 2]; im = im + P[c4 + 3];
                const bool forced = (jj == 0) || (jj == jtq) || (jj == jtq - 1); const bool valid = jj <= jtq;
                fsel[e] = forced && valid; cand[e] = valid && !forced; key[e] = cand[e] ? __float_as_uint(im) : 0u; }
            int remaining = 16 - (int)__popcll(__ballot(fsel[0])) - (int)__popcll(__ballot(fsel[1]));
            unsigned prefix = 0u;
#pragma unroll 1
            for (int bit = 30; bit >= 0; --bit) {
                const unsigned test = prefix | (1u << bit), himask = ~((1u << bit) - 1u);
                const int c = (int)__popcll(__ballot(cand[0] && ((key[0] & himask) == test))) + (int)__popcll(__ballot(cand[1] && ((key[1] & himask) == test)));
                if (c >= remaining) prefix = test; else remaining -= c;
            }
            const bool eq0 = cand[0] && key[0] == prefix, eq1 = cand[1] && key[1] == prefix;
            const unsigned long long beq0 = __ballot(eq0), beq1 = __ballot(eq1), ltm = (1ull << lane) - 1ull;
            const int rank0 = (int)__popcll(beq0 & ltm), rank1 = (int)__popcll(beq0) + (int)__popcll(beq1 & ltm);
            const bool sel0 = fsel[0] || (cand[0] && key[0] > prefix) || (eq0 && rank0 < remaining), sel1 = fsel[1] || (cand[1] && key[1] > prefix) || (eq1 && rank1 < remaining);
            const unsigned long long blo = __ballot(sel0), bhi = __ballot(sel1);
            if (ql == q4) { sello = blo; selhi = bhi; }
        }
        (void)impw;
        (void)selw;
        { LAS float* stash = (LAS float*)(lds + wid * 8192);
#pragma unroll
          for (int i = 0; i < 32; ++i) psw[i * 64 + lane] = stash[i * 64 + lane]; }
        __syncthreads();
        load_q(Qb, qr, tok, head, h);
        {
            const bf16_t* Kg = kvb + (size_t)((((1 * 2 + 0) * 4 + b) * 2 + kvh)) * SEQ * 64; const bf16_t* Vg = kvb + (size_t)((((1 * 2 + 1) * 4 + b) * 2 + kvh)) * SEQ * 64;
            const int nch = (t0 + 32 + 127) / 128;
            float lsum = 0.f; f32x16 o[2];
#pragma unroll
            for (int i = 0; i < 16; ++i) { o[0][i] = 0.f; o[1][i] = 0.f; }
            stream_keys<128, true>(tid, Kg, Vg, 0, nch, lds, [&](int k0, const LAS unsigned char* Kt, const LAS unsigned char* Vt) {
                if (k0 > tw + 3) return;
                const int bj = k0 >> 6;
                const bool selx = ((bj < 64 ? (sello >> bj) : (selhi >> (bj - 64))) & 1ull) != 0ull, sely = ((bj < 64 ? (sello >> (bj + 1)) : (selhi >> (bj - 63))) & 1ull) != 0ull;
                const bool anyx = __ballot(selx) != 0ull, anyy = (k0 + 64 <= tw + 3) && (__ballot(sely) != 0ull);
                if (anyx && anyy) {
                    f32x16 s0, s1, s2, s3; qk_pair(Kt, Qb, r, h, s0, s1); qk_pair(Kt + 64 * ROWB, Qb, r, h, s2, s3);
                    float p0[16], p1[16], p2[16], p3[16];
                    const float bx = selx ? -shs : -1e30f, by = sely ? -shs : -1e30f;
                    if (k0 + 127 > tw) {
                        unsigned vm0 = 0u, vm1 = 0u, vm2 = 0u, vm3 = 0u;
#pragma unroll
                        for (int i = 0; i < 16; ++i) { const int kp = k0 + crow(i, h); vm0 |= (kp <= t) ? (1u << i) : 0u; vm1 |= (kp + 32 <= t) ? (1u << i) : 0u; vm2 |= (kp + 64 <= t) ? (1u << i) : 0u; vm3 |= (kp + 96 <= t) ? (1u << i) : 0u; }
                        softmax_fx<true>(s0, vm0, bx, lsum, p0); softmax_fx<true>(s1, vm1, bx, lsum, p1); softmax_fx<true>(s2, vm2, by, lsum, p2); softmax_fx<true>(s3, vm3, by, lsum, p3);
                    } else { softmax_fx<false>(s0, 0u, bx, lsum, p0); softmax_fx<false>(s1, 0u, bx, lsum, p1); softmax_fx<false>(s2, 0u, by, lsum, p2); softmax_fx<false>(s3, 0u, by, lsum, p3); }
                    pv_pair(Vt, p0, p1, o, lane); pv_pair(Vt + 64 * ROWBV, p2, p3, o, lane);
                } else if (anyx || anyy) {
                    const int off = anyx ? 0 : 64; const int kk = k0 + off; const bool sel = anyx ? selx : sely;
                    f32x16 s0, s1; qk_pair(Kt + off * ROWB, Qb, r, h, s0, s1);
                    float p0[16], p1[16];
                    const float bias = sel ? -shs : -1e30f;
                    if (kk + 63 > tw) {
                        unsigned vm0 = 0u, vm1 = 0u;
#pragma unroll
                        for (int i = 0; i < 16; ++i) { const int kp = kk + crow(i, h); vm0 |= (kp <= t) ? (1u << i) : 0u; vm1 |= (kp + 32 <= t) ? (1u << i) : 0u; }
                        softmax_fx<true>(s0, vm0, bias, lsum, p0); softmax_fx<true>(s1, vm1, bias, lsum, p1);
                    } else { softmax_fx<false>(s0, 0u, bias, lsum, p0); softmax_fx<false>(s1, 0u, bias, lsum, p1); }
                    pv_pair(Vt + off * ROWBV, p0, p1, o, lane);
                }
            });
            const float ltot = lsum + __shfl_xor(lsum, 32, 64);
            const float sc = gates[tok * 48 + 16 + head] / fmaxf(ltot, 1e-30f);
#pragma unroll
            for (int i = 0; i < 16; ++i) { psw[i * 64 + lane] += sc * o[0][i]; psw[(16 + i) * 64 + lane] += sc * o[1][i]; }
        }
        {
            const bf16_t* Kg = kvb + (size_t)((((2 * 2 + 0) * 4 + b) * 2 + kvh)) * SEQ * 64; const bf16_t* Vg = kvb + (size_t)((((2 * 2 + 1) * 4 + b) * 2 + kvh)) * SEQ * 64;
            const int lo = t0 - 511 < 0 ? 0 : ((t0 - 511) & ~127); const int nch = (t0 + 32 - lo + 127) / 128;
            float lsum = 0.f; f32x16 o[2];
#pragma unroll
            for (int i = 0; i < 16; ++i) { o[0][i] = 0.f; o[1][i] = 0.f; }
            stream_keys<128>(tid, Kg, Vg, lo, nch, lds, [&](int k0, const LAS unsigned char* Kt, const LAS unsigned char* Vt) {
                if (k0 > tw + 3 || k0 + 63 < tw - 511) return;
                f32x16 s0, s1; qk_pair(Kt, Qb, r, h, s0, s1);
                float p0[16], p1[16];
                if (k0 + 63 > tw || k0 < tw + 3 - 511) {
                    unsigned vm0 = 0u, vm1 = 0u;
#pragma unroll
                    for (int i = 0; i < 16; ++i) { const int kp = k0 + crow(i, h); vm0 |= (kp <= t && t - kp < 512) ? (1u << i) : 0u; vm1 |= (kp + 32 <= t && t - kp - 32 < 512) ? (1u << i) : 0u; }
                    softmax_fx<true>(s0, vm0, -shw, lsum, p0); softmax_fx<true>(s1, vm1, -shw, lsum, p1);
                } else { softmax_fx<false>(s0, 0u, -shw, lsum, p0); softmax_fx<false>(s1, 0u, -shw, lsum, p1); }
                pv_pair(Vt, p0, p1, o, lane);
            });
            const float ltot = lsum + __shfl_xor(lsum, 32, 64);
            const float sc = gates[tok * 48 + 32 + head] / fmaxf(ltot, 1e-30f);
            bf16_t* op = outp + tok * DM + head * 64;
#pragma unroll
            for (int mt = 0; mt < 2; ++mt)
#pragma unroll
                for (int ig = 0; ig < 4; ++ig) { const int d0 = 32 * mt + 8 * ig + 4 * h; float w[4];
#pragma unroll
                    for (int j = 0; j < 4; ++j) w[j] = psw[(mt * 16 + 4 * ig + j) * 64 + lane] + sc * o[mt][4 * ig + j];
                    *(u32x2*)(op + d0) = (u32x2){pk2(w[0], w[1]), pk2(w[2], w[3])}; }
        }
    }
}


#define XB_TMO      128
#define XB_XCNT(j)  (256  + 64 * (j))
#define XB_XSUB(j)  (1280 + 64 * (j))
#define XB_XGEN(j)  (2304 + 64 * (j))
#define XB_TOP      3328
#define XB_TOPGEN   3392
#define XCD_BAR_WORDS 3456
#define XB_SPIN_CAP (1u << 18)
DI unsigned xb_ld(unsigned* p)              { return __hip_atomic_load(p, __ATOMIC_RELAXED, __HIP_MEMORY_SCOPE_AGENT); }
DI unsigned xb_add(unsigned* p, unsigned v) { return __hip_atomic_fetch_add(p, v, __ATOMIC_RELAXED, __HIP_MEMORY_SCOPE_AGENT); }
DI unsigned xb_xcc_id() { return (unsigned)__builtin_amdgcn_s_getreg((3 << 11) | 20) & 0xFu; }
#define XB_SPIN(cond, bar) do { unsigned _sp = 0; while (cond) { __builtin_amdgcn_s_sleep(1); \
    if ((++_sp & 255u) == 0u) { if (xb_ld(&(bar)[XB_TMO])) break; if (_sp > XB_SPIN_CAP) { atomicAdd(&(bar)[XB_TMO], 1u); break; } } } } while (0)
struct XcdBarrier { unsigned* bar; unsigned x; volatile LAS unsigned* st; };
DI XcdBarrier xcd_barrier_post(unsigned* bar, volatile LAS unsigned* st) {
    XcdBarrier b; b.bar = bar; b.x = xb_xcc_id(); b.st = st;
    if (threadIdx.x == 0) (void)xb_add(&bar[XB_XCNT(b.x)], 1u);
    return b;
}
DI void xcd_barrier_complete(unsigned* bar, unsigned x, unsigned& nloc, unsigned& nx) {
    const unsigned G = gridDim.x * gridDim.y * gridDim.z;
    unsigned sum, cnt, mine, sp = 0u;
    for (;;) {
        sum = 0u; cnt = 0u; mine = 0u;
#pragma unroll
        for (unsigned j = 0; j < 16; ++j) { const unsigned c = xb_ld(&bar[XB_XCNT(j)]); sum += c; cnt += (c > 0u) ? 1u : 0u; mine = (j == x) ? c : mine; }
        if (sum == G) break;
        __builtin_amdgcn_s_sleep(1);
        if ((++sp & 255u) == 0u) { if (xb_ld(&bar[XB_TMO])) break; if (sp > XB_SPIN_CAP) { atomicAdd(&bar[XB_TMO], 1u); break; } }
    }
    nloc = mine > 0u ? mine : 1u; nx = cnt > 0u ? cnt : 1u;
}
DI void xcd_barrier(const XcdBarrier& b, const int tid) {
    asm volatile("s_waitcnt vmcnt(0)" ::: "memory");
    __syncthreads();
    if (tid == 0) {
        unsigned* bar = b.bar;
        __builtin_amdgcn_s_waitcnt(0);
        unsigned nloc = b.st[0], nx = b.st[1];
        if (nloc == 0u) { xcd_barrier_complete(bar, b.x, nloc, nx); b.st[0] = nloc; b.st[1] = nx; }
        const unsigned old = xb_add(&bar[XB_XSUB(b.x)], 1u);
        const unsigned gen = old / nloc;
        if (old + 1u == (gen + 1u) * nloc) {
            __builtin_amdgcn_fence(__ATOMIC_RELEASE, "agent");
            asm volatile("s_waitcnt vmcnt(0)" ::: "memory");
            const unsigned og = xb_add(&bar[XB_TOP], 1u);
            const unsigned tg = og / nx;
            if (og + 1u == (tg + 1u) * nx) xb_add(&bar[XB_TOPGEN], 1u);
            else XB_SPIN(xb_ld(&bar[XB_TOPGEN]) == tg, bar);
            __builtin_amdgcn_fence(__ATOMIC_ACQUIRE, "agent");
            xb_add(&bar[XB_XGEN(b.x)], 1u);
            asm volatile("s_waitcnt vmcnt(0)" ::: "memory");
        } else {
            XB_SPIN(xb_ld(&bar[XB_XGEN(b.x)]) == gen, bar);
            __builtin_amdgcn_fence(__ATOMIC_ACQUIRE, "agent");
            asm volatile("s_waitcnt vmcnt(0)" ::: "memory");
        }
    }
    __syncthreads();
}

DI const float* modp(KP p, int l, int sub, int which) { return (const float*)(p->ws + WS_MODF) + l * 9216 + sub * 3072 + which * 1024; }
template <class Epi>
DI void run_gemm(const int tid, LAS unsigned char* lds, const bf16_t* A, int lda, const bf16_t* Bt, int ldb, int M, int N, int K, const Epi& E, int G, int c) {
    int Kv = K; asm volatile("" : "+s"(Kv));
    pg8::Gemm g; g.A = A; g.Bt = Bt; g.M = M; g.N = N; g.K = Kv; g.lda = lda; g.ldb = ldb;
    if (lda == 64) { g.kstepA = 256 * 64 * 2; g.hstepA = 128 * 64 * 2; g.tstepA = (size_t)(K / 64) * (256 * 64 * 2); }
    else { g.kstepA = 128; g.hstepA = (size_t)128 * lda * 2; g.tstepA = (size_t)256 * lda * 2; }
    pg8::StaticOrder S; S.init(M, N, G, c);
    pg8::gemm_phase<Epi>(lds, g, S, E, tid);
}
constexpr int NPHASE = 21;
__global__ void __launch_bounds__(512, 2) mega(const Params p_unused) {
    KP p0 = (KP)__builtin_amdgcn_kernarg_segment_ptr();
    extern __shared__ __attribute__((aligned(16))) unsigned char shm[];
    LAS unsigned char* lds = (LAS unsigned char*)shm;
    cg::grid_group grid = cg::this_grid();
    volatile LAS unsigned* xst = (volatile LAS unsigned*)(lds + 163824);
    if (threadIdx.x == 0) { xst[0] = 0u; xst[1] = 0u; xst[2] = 0u; xst[3] = 0u; }
    __syncthreads();
    const XcdBarrier xb = xcd_barrier_post((unsigned*)(p0->ws + WS_BAR), xst);
    const int ph_hi = p0->ph_hi;
    const int wid_s = __builtin_amdgcn_readfirstlane((int)threadIdx.x >> 6);
    { int tid0 = threadIdx.x, bc0 = blockIdx.x, G0 = gridDim.x; asm volatile("" : "+v"(tid0)); asm volatile("" : "+s"(bc0)); asm volatile("" : "+s"(G0)); phase_prep(p0, lds, tid0, bc0, G0); }
    grid.sync();
    for (int phi = 1; phi < ph_hi; ++phi) {
        int ph = phi;
#ifdef PROBE_PH
        if (phi > PROBE_PH) ph = phi - 1;
#endif
        KP p = p0; asm volatile("" : "+s"(p));
        unsigned char* ws = p->ws;
        const float* cosT = (const float*)(ws + WS_ROPEC); const float* sinT = (const float*)(ws + WS_ROPES);
        bf16_t* U = (bf16_t*)(p->out); bf16_t* HID = (bf16_t*)(ws + WS_HID); unsigned short* H16 = (unsigned short*)(ws + WS_H16);
        float* ssq = (float*)(ws + WS_SSPA); const float* bv = (const float*)(ws + WS_BV); const float* gsv = (const float*)(ws + WS_GS);
        unsigned zz = 0u; asm volatile("" : "+v"(zz));
        int tid = (wid_s << 6) | (int)__builtin_amdgcn_mbcnt_hi(~0u, __builtin_amdgcn_mbcnt_lo(~0u, zz)), bc = blockIdx.x, G = gridDim.x;
        asm volatile("" : "+v"(tid)); asm volatile("" : "+s"(bc)); asm volatile("" : "+s"(G));
        if (phi > 1) xcd_barrier(xb, tid);
        switch (ph) {
        case 1: phase_modfinal(p, tid, bc, G); break;
        case 2: phase_bias(p, lds, tid, bc, G); break;
        case 3: { EpiSwiGLU e{HID, ssq + 0 * NTOK, bv + 0 * BV_FFN}; run_gemm(tid, lds, U, DM, (const bf16_t*)(ws + WS_WIN) + (size_t)0 * 5632 * DM, DM, NTOK, 5632, DM, e, G, bc); } break;
        case 4: { EpiResidN<false, true> e{p->x, H16, modp(p, 0, 0, 2), 0.5f, ssq + 1 * NTOK, U, gsv + 1 * 4096, U, gsv + 1 * 4096}; run_gemm(tid, lds, HID, 64, (const bf16_t*)(ws + WS_WOUT) + (size_t)0 * DM * DFF, DFF, NTOK, DM, DFF, e, G, bc); } break;
        case 5: case 7: case 9: { const int g = (ph - 5) >> 1;
            EpiQKV e{(bf16_t*)(ws + WS_QKVG), p->a_q_gain + g * 64, p->a_k_gain + g * 64, cosT, sinT, ssq + 1 * NTOK, bv + BV_QKV, g * 3072};
            run_gemm(tid, lds, U, DM, (const bf16_t*)(ws + WS_WQKV) + (size_t)g * 3072 * DM, DM, NTOK, 3072, DM, e, G, bc); } break;
        case 6: case 8: case 10: phase_dilated(p, lds, (ph - 6) >> 1, tid, bc, G); break;
        case 11: { EpiResidN<false, false> e{H16, H16, modp(p, 0, 1, 2), 1.0f, ssq + 2 * NTOK, U, gsv + 2 * 4096, U, gsv + 2 * 4096}; run_gemm(tid, lds, (const bf16_t*)(ws + WS_OACC), DM, (const bf16_t*)(ws + WS_WOA), DM, NTOK, DM, DM, e, G, bc); } break;
        case 12: { EpiSwiGLU e{HID, ssq + 2 * NTOK, bv + 1 * BV_FFN}; run_gemm(tid, lds, U, DM, (const bf16_t*)(ws + WS_WIN) + (size_t)1 * 5632 * DM, DM, NTOK, 5632, DM, e, G, bc); } break;
        case 13: { EpiResidN<true, false> e{H16, H16, modp(p, 0, 2, 2), 0.5f, ssq + 3 * NTOK, U, gsv + 3 * 4096, (bf16_t*)(ws + WS_UKV), gsv + 4 * 4096}; run_gemm(tid, lds, HID, 64, (const bf16_t*)(ws + WS_WOUT) + (size_t)1 * DM * DFF, DFF, NTOK, DM, DFF, e, G, bc); } break;
        case 14: { EpiKV ek{(bf16_t*)(ws + WS_KV), p->kv_k_gain, cosT, sinT, ssq + 3 * NTOK, bv + BV_KV}; run_gemm(tid, lds, (const bf16_t*)(ws + WS_UKV), DM, (const bf16_t*)(ws + WS_WKV), DM, NTOK, 768, DM, ek, G, bc);
                   EpiSwiGLU e{HID, ssq + 3 * NTOK, bv + 2 * BV_FFN}; run_gemm(tid, lds, U, DM, (const bf16_t*)(ws + WS_WIN) + (size_t)2 * 5632 * DM, DM, NTOK, 5632, DM, e, G, bc); } break;
        case 15: { if (bc < 32) { const int which = bc >> 4; EpiCmp1 ec{(bf16_t*)(ws + WS_HC) + (size_t)which * 4096 * 256, (const float*)(ws + WS_BIAS1) + which * 128};
                       run_gemm(tid, lds, (const bf16_t*)(ws + WS_KV) + (size_t)which * 4096 * 1024, 1024, (const bf16_t*)(ws + WS_WPHI1) + (size_t)which * 256 * 2048, 2048, 4096, 256, 2048, ec, 16, bc & 15); }
                   EpiResidN<false, false> e{H16, H16, modp(p, 1, 0, 2), 0.5f, ssq + 5 * NTOK, U, gsv + 5 * 4096, U, gsv + 5 * 4096}; run_gemm(tid, lds, HID, 64, (const bf16_t*)(ws + WS_WOUT) + (size_t)2 * DM * DFF, DFF, NTOK, DM, DFF, e, G, bc); } break;
        case 16: { if (bc < 16) { EpiCmp2<true> ec{(bf16_t*)(ws + WS_CMP), p->kv_k_gain};
                       run_gemm(tid, lds, (const bf16_t*)(ws + WS_HC), 256, (const bf16_t*)(ws + WS_WPHI2), 256, 4096, 256, 256, ec, 16, bc & 15); }
                   else if (bc < 32) { EpiCmp2<false> ec{(bf16_t*)(ws + WS_CMP) + (size_t)4096 * 64, p->kv_k_gain};
                       run_gemm(tid, lds, (const bf16_t*)(ws + WS_HC) + (size_t)4096 * 256, 256, (const bf16_t*)(ws + WS_WPHI2) + (size_t)256 * 256, 256, 4096, 256, 256, ec, 16, bc & 15); }
                   EpiQG e{(bf16_t*)(ws + WS_QN), (bf16_t*)(ws + WS_QR), (float*)(ws + WS_GATES), p->b_q_gain, cosT, sinT, ssq + 5 * NTOK, bv + BV_QG};
                   run_gemm(tid, lds, U, DM, (const bf16_t*)(ws + WS_WQG), DM, NTOK, 1280, DM, e, G, bc); } break;
        case 17: phase_nsa(p, lds, tid, bc, G); break;
        case 18: { EpiResidN<false, false> e{H16, H16, modp(p, 1, 1, 2), 1.0f, ssq + 6 * NTOK, U, gsv + 6 * 4096, U, gsv + 6 * 4096}; run_gemm(tid, lds, (const bf16_t*)(ws + WS_UKV), DM, (const bf16_t*)(ws + WS_WOB), DM, NTOK, DM, DM, e, G, bc); } break;
        case 19: { EpiSwiGLU e{HID, ssq + 3 * NTOK + 3 * NTOK, bv + 3 * BV_FFN}; run_gemm(tid, lds, U, DM, (const bf16_t*)(ws + WS_WIN) + (size_t)3 * 5632 * DM, DM, NTOK, 5632, DM, e, G, bc); } break;
        case 20: { EpiResid e{H16, p->out, modp(p, 1, 2, 2), 0.5f}; run_gemm(tid, lds, HID, 64, (const bf16_t*)(ws + WS_WOUT) + (size_t)3 * DM * DFF, DFF, NTOK, DM, DFF, e, G, bc); } break;
        default: break;
        }
    }
}

static void set_job(Job& j, const float* src, bf16_t* dst, int nsrc, int ksrc, int kdst, int ndst, int perm) { j.src = src; j.dst = dst; j.nsrc = nsrc; j.ksrc = ksrc; j.kdst = kdst; j.ndst = ndst; j.perm = perm; j.pad = 0; }
extern "C" void kernel_launch(void* const* d_in, const int* in_sizes, int n_in, void* d_out, int out_size, void* d_ws, size_t ws_size, hipStream_t stream) {
    static int grid_blocks = 0;
    if (grid_blocks == 0) {
        if (n_in != 22 || ws_size < WS_NEED) { fprintf(stderr, "kernel_launch: unexpected inputs (%d) or workspace (%zu)\n", n_in, ws_size); grid_blocks = -1; return; }
        int dev = 0, cus = 0, per_cu = 0;
        (void)hipGetDevice(&dev); (void)hipDeviceGetAttribute(&cus, hipDeviceAttributeMultiprocessorCount, dev);
        if (hipFuncSetAttribute((const void*)mega, hipFuncAttributeMaxDynamicSharedMemorySize, LDS_BYTES) != hipSuccess) { fprintf(stderr, "kernel_launch: hipFuncSetAttribute failed\n"); grid_blocks = -1; return; }
        if (hipOccupancyMaxActiveBlocksPerMultiprocessor(&per_cu, (const void*)mega, 512, LDS_BYTES) != hipSuccess || per_cu < 1) { fprintf(stderr, "kernel_launch: occupancy query says %d\n", per_cu); per_cu = 1; }
        (void)hipGetLastError();
        grid_blocks = cus * 1;
    }
    if (grid_blocks < 0) return;
    Params p; memset(&p, 0, sizeof(p));
    const float* const* in = (const float* const*)d_in;
    p.x = in[0]; p.c = in[1]; p.norm_g = in[2]; p.w_ada = in[3]; p.b_ada = in[4]; p.ffn_w_in = in[5]; p.ffn_w_out = in[6]; p.a_w_qkv = in[7]; p.a_q_gain = in[8]; p.a_k_gain = in[9];
    p.a_w_o = in[10]; p.kv_norm_g = in[11]; p.w_ada_kv = in[12]; p.b_ada_kv = in[13]; p.w_kv = in[14]; p.kv_k_gain = in[15]; p.cmp_pos = in[16]; p.phi_w1 = in[17]; p.phi_w2 = in[18];
    p.b_w_qg = in[19]; p.b_q_gain = in[20]; p.b_w_o = in[21];
    p.out = (float*)d_out; p.ws = (unsigned char*)d_ws;
    unsigned char* ws = (unsigned char*)d_ws;
    int j = 0;
    for (int i = 0; i < 4; ++i) set_job(p.jobs[j++], p.ffn_w_in + (size_t)i * DM * 5632, (bf16_t*)(ws + WS_WIN) + (size_t)i * 5632 * DM, 5632, DM, DM, 5632, 2);
    for (int i = 0; i < 4; ++i) set_job(p.jobs[j++], p.ffn_w_out + (size_t)i * DFF * DM, (bf16_t*)(ws + WS_WOUT) + (size_t)i * DM * DFF, DM, DFF, DFF, DM, 0);
    set_job(p.jobs[j++], p.a_w_qkv, (bf16_t*)(ws + WS_WQKV), 9216, DM, DM, 9216, 1);
    set_job(p.jobs[j++], p.a_w_o, (bf16_t*)(ws + WS_WOA), DM, DM, DM, DM, 0);
    set_job(p.jobs[j++], p.w_kv, (bf16_t*)(ws + WS_WKV), 768, DM, DM, 768, 1);
    set_job(p.jobs[j++], p.b_w_qg, (bf16_t*)(ws + WS_WQG), 1072, DM, DM, 1280, 3);
    set_job(p.jobs[j++], p.b_w_o, (bf16_t*)(ws + WS_WOB), DM, DM, DM, DM, 0);
    for (int i = 0; i < 2; ++i) set_job(p.jobs[j++], p.phi_w1 + (size_t)i * 2048 * 128, (bf16_t*)(ws + WS_WPHI1) + (size_t)i * 256 * 2048, 128, 2048, 2048, 256, 0);
    for (int i = 0; i < 2; ++i) set_job(p.jobs[j++], p.phi_w2 + (size_t)i * 128 * 64, (bf16_t*)(ws + WS_WPHI2) + (size_t)i * 256 * 256, 64, 128, 256, 256, 1);
    p.ph_lo = 0; p.ph_hi = NPHASE;
#ifdef PROBE_PH
    p.ph_hi = NPHASE + 1;
#endif
    if (hipMemsetAsync(ws + WS_BAR, 0, XCD_BAR_WORDS * 4, stream) != hipSuccess) { fprintf(stderr, "kernel_launch: memset of barrier words failed\n"); return; }
    void* args[] = {(void*)&p};
    hipError_t e = hipLaunchCooperativeKernel((const void*)mega, dim3(grid_blocks), dim3(512), args, LDS_BYTES, stream);
    if (e != hipSuccess) fprintf(stderr, "cooperative launch failed: %s (grid %d)\n", hipGetErrorString(e), grid_blocks);
}
```

```cpp
#include <hip/hip_runtime.h>
#include <hip/hip_cooperative_groups.h>
#include <cstdio>
#include <cstring>
namespace cg = cooperative_groups;

#define DI __device__ __forceinline__
#define LAS __attribute__((address_space(3)))
typedef unsigned short bf16_t;
typedef short bf16x8 __attribute__((ext_vector_type(8)));
typedef short s16x4 __attribute__((ext_vector_type(4)));
typedef float f32x2 __attribute__((ext_vector_type(2)));
typedef float f32x4 __attribute__((ext_vector_type(4)));
typedef float f32x16 __attribute__((ext_vector_type(16)));
typedef unsigned u32x2 __attribute__((ext_vector_type(2)));
typedef unsigned u32x4 __attribute__((ext_vector_type(4)));
typedef __bf16 bf16x2_t __attribute__((ext_vector_type(2)));

constexpr int NB = 4, SEQ = 8192, DM = 1024, NTOK = NB * SEQ, DFF = 2816;
constexpr int MODW = 20480;
constexpr float EPSN = 1e-6f;
constexpr float SC2 = 0.125f * 1.44269504088896f;
constexpr float LN2 = 0.69314718055994531f;
constexpr int LDS_BYTES = 151552;
constexpr int BV_FFN = 4 * 5632, BV_QKV = 4 * BV_FFN, BV_KV = BV_QKV + 4 * 9216, BV_QG = BV_KV + 4 * 768;

constexpr size_t MiB = 1ull << 20;
constexpr size_t WS_WIN = 0;
constexpr size_t WS_WOUT = 44 * MiB;
constexpr size_t WS_WQKV = 66 * MiB;
constexpr size_t WS_WOA = 84 * MiB;
constexpr size_t WS_WKV = 86 * MiB;
constexpr size_t WS_WQG = 88 * MiB;
constexpr size_t WS_WOB = 91 * MiB;
constexpr size_t WS_WPHI1 = 93 * MiB;
constexpr size_t WS_WPHI2 = 95 * MiB;
constexpr size_t WS_MODP = 96 * MiB;
constexpr size_t WS_SSPA = 96 * MiB;
constexpr size_t WS_SSPB = 98 * MiB;
constexpr size_t WS_BV = 100 * MiB;
constexpr size_t WS_GS = 100 * MiB + 768 * 1024;
constexpr size_t WS_MODF = 101 * MiB;
constexpr size_t WS_ROPEC = 102 * MiB;
constexpr size_t WS_ROPES = 103 * MiB;
constexpr size_t WS_BIAS1 = 104 * MiB;
constexpr size_t WS_LSE = 105 * MiB;
constexpr size_t WS_GATES = 106 * MiB;
constexpr size_t WS_H16 = 112 * MiB;
constexpr size_t WS_BIG = 176 * MiB;
constexpr size_t WS_HID = WS_BIG;
constexpr size_t WS_QKVG = WS_BIG;
constexpr size_t WS_OACC = 368 * MiB;
constexpr size_t WS_UKV = 352 * MiB;
constexpr size_t WS_KV = 416 * MiB;
constexpr size_t WS_HC = 466 * MiB;
constexpr size_t WS_CMP = 470 * MiB;
constexpr size_t WS_QN = WS_BIG;
constexpr size_t WS_QR = 240 * MiB;
constexpr size_t WS_BAR = 472 * MiB;
constexpr size_t WS_NEED = 473 * MiB;

struct Job { const float* src; bf16_t* dst; int nsrc, ksrc, kdst, ndst, perm, pad; };
constexpr int NJOBS = 17;
struct Params {
    const float *x, *c, *norm_g, *w_ada, *b_ada, *ffn_w_in, *ffn_w_out, *a_w_qkv, *a_q_gain, *a_k_gain, *a_w_o, *kv_norm_g, *w_ada_kv,
        *b_ada_kv, *w_kv, *kv_k_gain, *cmp_pos, *phi_w1, *phi_w2, *b_w_qg, *b_q_gain, *b_w_o;
    float* out; unsigned char* ws;
    int ph_lo, ph_hi;
    Job jobs[NJOBS];
};

typedef const __attribute__((address_space(4))) Params* KP;
DI unsigned pk2(float a, float b) { f32x2 f = {a, b}; bf16x2_t v = __builtin_convertvector(f, bf16x2_t); return __builtin_bit_cast(unsigned, v); }
typedef _Float16 h16x2 __attribute__((ext_vector_type(2)));
DI unsigned pkh2(float a, float b) { f32x2 f = {a, b}; h16x2 v = __builtin_convertvector(f, h16x2); return __builtin_bit_cast(unsigned, v); }
DI float h_lo(unsigned u) { h16x2 v = __builtin_bit_cast(h16x2, u); return (float)v[0]; }
DI float h_hi(unsigned u) { h16x2 v = __builtin_bit_cast(h16x2, u); return (float)v[1]; }
DI float bf_lo(unsigned u) { return __uint_as_float(u << 16); }
DI float bf_hi(unsigned u) { return __uint_as_float(u & 0xffff0000u); }
DI float wave_sum(float v) { for (int o = 32; o >= 1; o >>= 1) v += __shfl_xor(v, o, 64); return v; }
DI float sum8(float v) {
    v += __int_as_float(__builtin_amdgcn_update_dpp(0, __float_as_int(v), 0x141, 0xf, 0xf, true));
    v += __int_as_float(__builtin_amdgcn_update_dpp(0, __float_as_int(v), 0xB1, 0xf, 0xf, true));
    v += __int_as_float(__builtin_amdgcn_update_dpp(0, __float_as_int(v), 0x4E, 0xf, 0xf, true));
    return v;
}
DI int crow(int i, int h) { return (i & 3) + 8 * (i >> 2) + 4 * h; }

namespace pg8 {
constexpr int BM = 256, BK = 64, HALF = 128, HTB = HALF * BK * 2, STAGE_BYTES = 8 * HTB, NXCD = 8, WGM = 8;
DI int lds_byte(int r, int c) { const int st = (r >> 4) * 2 + (c >> 5), rr = r & 15, cc = c & 31, ob = rr * 64 + cc * 2; return st * 1024 + (ob ^ (((ob >> 9) & 1) << 5)); }
DI void stage_rc(int b, int& R, int& C) { const int st = b / 1024, sb = b % 1024, swz = sb ^ (((sb >> 9) & 1) << 5); R = (st >> 1) * 16 + swz / 64; C = (st & 1) * 32 + (swz % 64) / 2; }
DI int perm32(int rho) { const int n = rho >> 4, i = rho & 15; return 8 * (i >> 2) + 4 * n + (i & 3); }
struct Unit { int pm, pn; };
struct Gemm { const bf16_t* A; const bf16_t* Bt; int M, N, K, lda, ldb; size_t kstepA, hstepA, tstepA; };
struct StaticOrder {
    int nM, nN, nwg, G, c;
    DI void init(int M, int N, int G_, int c_) { nM = M / BM; nN = N / BM; nwg = nM * nN; G = G_; c = c_; }
    DI bool next(int i, Unit& u) const {
        const long L = (long)i * G + c; if (L >= nwg) return false;
        int wgid = (int)L; { const int q = nwg / NXCD, r = nwg % NXCD, xcd = wgid % NXCD, off = wgid / NXCD; wgid = (xcd < r ? xcd * (q + 1) : r * (q + 1) + (xcd - r) * q) + off; }
        const int nig = WGM * nN, gid = wgid / nig, fm = gid * WGM, gsz = (nM - fm) < WGM ? (nM - fm) : WGM;
        u.pm = fm + ((wgid % nig) % gsz); u.pn = (wgid % nig) / gsz; return true;
    }
};
template <class Epi>
DI void gemm_phase(LAS unsigned char* lds, const Gemm g, const StaticOrder& S, const Epi& E, const int tid) {
    const int wid = __builtin_amdgcn_readfirstlane(tid >> 6), lane = tid & 63, wr = wid >> 2, wc = wid & 3, fr = lane & 15, fq = lane >> 4;
    const int K = g.K, nt = K / BK;
    unsigned voffA[2], voffB[2];
#pragma unroll
    for (int i = 0; i < 2; ++i) { int R, C; stage_rc(tid * 16 + i * 8192, R, C); const int Rb = (R & ~31) + perm32(R & 31);
        voffA[i] = (unsigned)(R * g.lda + C) * 2u; voffB[i] = (unsigned)(Rb * g.ldb + C) * 2u; }
    const size_t kstep = (size_t)(BK * 2), kstepA = g.kstepA;
    const size_t hstepA = g.hstepA, hstepB = (size_t)HALF * g.ldb * 2;
    const size_t tstepA = g.tstepA, tstepB = 2 * hstepB;
    const unsigned ldsw = (unsigned)wid * 1024u;
    const int aoff = lds_byte(wr * 64 + fr, fq * 8), boff = lds_byte(wc * 32 + fr, fq * 8);
#define PG8_SA(b, h) (((b) * 2 + (h)) * HTB)
#define PG8_SB(b, h) ((4 + (b) * 2 + (h)) * HTB)
#define PG8_STAGE(bufoff, gbase, voff) do { _Pragma("unroll") for (int _i = 0; _i < 2; ++_i) \
        __builtin_amdgcn_global_load_lds((const unsigned*)((const char*)(gbase) + (voff)[_i]), (LAS unsigned*)(lds + (bufoff) + ldsw + _i * 8192), 16, 0, 0); } while (0)
#define PG8_LDA(dst, b, h) do { _Pragma("unroll") for (int m = 0; m < 4; ++m) _Pragma("unroll") for (int k = 0; k < 2; ++k) dst[m][k] = *(const LAS bf16x8*)(lds + PG8_SA(b, h) + aoff + m * 2048 + k * 1024); } while (0)
#define PG8_LDB(dst, b, h) do { _Pragma("unroll") for (int n = 0; n < 2; ++n) _Pragma("unroll") for (int k = 0; k < 2; ++k) dst[n][k] = *(const LAS bf16x8*)(lds + PG8_SB(b, h) + boff + n * 2048 + k * 1024); } while (0)
#define PG8_MMA(ai, bj, At, Bt) do { __builtin_amdgcn_s_setprio(1); _Pragma("unroll") for (int m = 0; m < 4; ++m) _Pragma("unroll") for (int n = 0; n < 2; ++n) _Pragma("unroll") for (int k = 0; k < 2; ++k) \
        acc[ai][bj][m][n] = __builtin_amdgcn_mfma_f32_16x16x32_bf16(Bt[n][k], At[m][k], acc[ai][bj][m][n], 0, 0, 0); __builtin_amdgcn_s_setprio(0); } while (0)
#define PG8_WAIT_V(n) asm volatile("s_waitcnt vmcnt(" #n ")" ::: "memory")
#define PG8_WAIT_L(n) asm volatile("s_waitcnt lgkmcnt(" #n ")" ::: "memory")
#define PG8_BAR __builtin_amdgcn_s_barrier()
#define PG8_SCHED __builtin_amdgcn_sched_barrier(0)
    Unit cur, nxt; int ui = 0;
    if (!S.next(0, cur)) return;
    f32x4 acc[2][2][4][2];
#pragma unroll
    for (int a = 0; a < 2; ++a)
#pragma unroll
        for (int b = 0; b < 2; ++b)
#pragma unroll
            for (int m = 0; m < 4; ++m)
#pragma unroll
                for (int n = 0; n < 2; ++n) acc[a][b][m][n] = (f32x4){0.f, 0.f, 0.f, 0.f};
    bf16x8 At[4][2], B0[2][2], B1[2][2];
    const char* cA = (const char*)g.A + (size_t)cur.pm * tstepA; const char* cB = (const char*)g.Bt + (size_t)cur.pn * tstepB;
    PG8_STAGE(PG8_SB(0, 0), cB, voffB); PG8_STAGE(PG8_SA(0, 0), cA, voffA); PG8_STAGE(PG8_SB(0, 1), cB + hstepB, voffB); PG8_STAGE(PG8_SA(0, 1), cA + hstepA, voffA);
    if (wr == 1) PG8_BAR;
    PG8_WAIT_V(4); PG8_BAR;
    PG8_STAGE(PG8_SB(1, 0), cB + kstep, voffB); PG8_STAGE(PG8_SA(1, 0), cA + kstepA, voffA); PG8_STAGE(PG8_SB(1, 1), cB + hstepB + kstep, voffB);
    PG8_WAIT_V(6); PG8_BAR;
    for (;;) {
        const bool has_next = S.next(ui + 1, nxt);
        const char* nA = has_next ? (const char*)g.A + (size_t)nxt.pm * tstepA : cA; const char* nB = has_next ? (const char*)g.Bt + (size_t)nxt.pn * tstepB : cB;
        for (int t = 0; t < nt; t += 2) {
            const bool last = (t == nt - 2);
            const char* a1 = cA + (size_t)(t + 1) * kstepA;
            const char* a2 = last ? nA : cA + (size_t)(t + 2) * kstepA; const char* b2 = last ? nB : cB + (size_t)(t + 2) * kstep;
            const char* a3 = a2 + kstepA; const char* b3 = b2 + kstep;
            PG8_LDB(B0, 0, 0); PG8_SCHED; PG8_LDA(At, 0, 0); PG8_STAGE(PG8_SA(1, 1), a1 + hstepA, voffA);
            PG8_WAIT_L(8); PG8_BAR; PG8_WAIT_L(0); PG8_MMA(0, 0, At, B0); PG8_BAR; PG8_SCHED;
            PG8_LDB(B1, 0, 1); PG8_STAGE(PG8_SB(0, 0), b2, voffB);
            PG8_BAR; PG8_WAIT_L(0); PG8_MMA(0, 1, At, B1); PG8_BAR;
            PG8_LDA(At, 0, 1); PG8_STAGE(PG8_SA(0, 0), a2, voffA);
            PG8_BAR; PG8_WAIT_L(0); PG8_MMA(1, 0, At, B0); PG8_BAR; PG8_SCHED;
            PG8_STAGE(PG8_SB(0, 1), b2 + hstepB, voffB);
            PG8_WAIT_V(6); PG8_BAR; PG8_MMA(1, 1, At, B1); PG8_BAR;
            PG8_LDB(B0, 1, 0); PG8_SCHED; PG8_LDA(At, 1, 0); PG8_STAGE(PG8_SA(0, 1), a2 + hstepA, voffA);
            PG8_WAIT_L(8); PG8_BAR; PG8_WAIT_L(0); PG8_MMA(0, 0, At, B0); PG8_BAR; PG8_SCHED;
            PG8_LDB(B1, 1, 1); PG8_STAGE(PG8_SB(1, 0), b3, voffB);
            PG8_BAR; PG8_WAIT_L(0); PG8_MMA(0, 1, At, B1); PG8_BAR;
            PG8_LDA(At, 1, 1); PG8_STAGE(PG8_SA(1, 0), a3, voffA);
            PG8_BAR; PG8_WAIT_L(0); PG8_MMA(1, 0, At, B0); PG8_BAR; PG8_SCHED;
            PG8_STAGE(PG8_SB(1, 1), b3 + hstepB, voffB);
            PG8_WAIT_V(6); PG8_BAR; PG8_MMA(1, 1, At, B1); PG8_BAR;
        }
        { int fr_e = fr, fq_e = fq; asm volatile("" : "+v"(fr_e), "+v"(fq_e)); E(acc, cur, wr, wc, fr_e, fq_e); }
        if (!has_next) break;
#pragma unroll
        for (int a = 0; a < 2; ++a)
#pragma unroll
            for (int b = 0; b < 2; ++b)
#pragma unroll
                for (int m = 0; m < 4; ++m)
#pragma unroll
                    for (int n = 0; n < 2; ++n) acc[a][b][m][n] = (f32x4){0.f, 0.f, 0.f, 0.f};
        cur = nxt; cA = nA; cB = nB; ++ui;
    }
    PG8_WAIT_V(0);
    if (wr == 0) PG8_BAR;
    PG8_BAR;
#undef PG8_SA
#undef PG8_SB
#undef PG8_STAGE
#undef PG8_LDA
#undef PG8_LDB
#undef PG8_MMA
#undef PG8_WAIT_V
#undef PG8_WAIT_L
#undef PG8_BAR
#undef PG8_SCHED
}
}
using pg8::Unit;
typedef f32x4 AccT[2][2][4][2];

DI void head_norm_rope(float (&v)[2][8], const float* gain, bool do_rope, int pos, int fq, const float* cosT, const float* sinT) {
    float ss = 0.f;
#pragma unroll
    for (int bj = 0; bj < 2; ++bj)
#pragma unroll
        for (int e = 0; e < 8; ++e) ss += v[bj][e] * v[bj][e];
    ss += __shfl_xor(ss, 16, 64); ss += __shfl_xor(ss, 32, 64);
    const float rinv = rsqrtf(ss * (1.0f / 64.0f) + EPSN);
#pragma unroll
    for (int bj = 0; bj < 2; ++bj) {
        const f32x4 g0 = *(const f32x4*)(gain + 32 * bj + 8 * fq), g1 = *(const f32x4*)(gain + 32 * bj + 8 * fq + 4);
#pragma unroll
        for (int e = 0; e < 4; ++e) { v[bj][e] = v[bj][e] * rinv * g0[e]; v[bj][4 + e] = v[bj][4 + e] * rinv * g1[e]; }
    }
    if (do_rope) {
        const f32x4 c0 = *(const f32x4*)(cosT + pos * 32 + 8 * fq), c1 = *(const f32x4*)(cosT + pos * 32 + 8 * fq + 4);
        const f32x4 s0 = *(const f32x4*)(sinT + pos * 32 + 8 * fq), s1 = *(const f32x4*)(sinT + pos * 32 + 8 * fq + 4);
#pragma unroll
        for (int e = 0; e < 8; ++e) { const float c = e < 4 ? c0[e & 3] : c1[e & 3], s = e < 4 ? s0[e & 3] : s1[e & 3];
            const float x1 = v[0][e], x2 = v[1][e]; v[0][e] = x1 * c - x2 * s; v[1][e] = x1 * s + x2 * c; }
    }
}
DI u32x4 pack8(const float* v) { u32x4 w; w.x = pk2(v[0], v[1]); w.y = pk2(v[2], v[3]); w.z = pk2(v[4], v[5]); w.w = pk2(v[6], v[7]); return w; }
#define ACC16(v, acc, ai, m) _Pragma("unroll") for (int bj = 0; bj < 2; ++bj) _Pragma("unroll") for (int n = 0; n < 2; ++n) _Pragma("unroll") for (int j = 0; j < 4; ++j) v[bj][4 * n + j] = acc[ai][bj][m][n][j]

DI float row_rinv(const float* ss, int row) { return rsqrtf(ss[row] * (1.0f / DM) + EPSN); }
#define ACC16B(v, acc, ai, m, ri, b00, b01, b10, b11) _Pragma("unroll") for (int j = 0; j < 4; ++j) { v[0][j] = fmaf(acc[ai][0][m][0][j], ri, b00[j]); v[0][4 + j] = fmaf(acc[ai][0][m][1][j], ri, b01[j]); v[1][j] = fmaf(acc[ai][1][m][0][j], ri, b10[j]); v[1][4 + j] = fmaf(acc[ai][1][m][1][j], ri, b11[j]); }
#define LOAD_RI(ri, ssp, row0) float ri[8]; _Pragma("unroll") for (int q_ = 0; q_ < 8; ++q_) ri[q_] = row_rinv(ssp, (row0) + (q_ >> 2) * 128 + (q_ & 3) * 16)
#define LOAD_B4(bp) const f32x4 b00 = *(const f32x4*)(bp), b01 = *(const f32x4*)((bp) + 4), b10 = *(const f32x4*)((bp) + 32), b11 = *(const f32x4*)((bp) + 36)
struct EpiSwiGLU {
    bf16_t* hid; const float* ssp; const float* bias;
    DI void operator()(const AccT& acc, const Unit& u, int wr, int wc, int fr, int fq) const {
        const int row0 = u.pm * 256 + wr * 64 + fr, col0 = u.pn * 128 + wc * 32 + 8 * fq;
        const float* bp = bias + (size_t)((u.pm * 256) >> 13) * 5632 + col0;
        const f32x4 b00 = *(const f32x4*)(bp), b01 = *(const f32x4*)(bp + 4), b10 = *(const f32x4*)(bp + DFF), b11 = *(const f32x4*)(bp + DFF + 4);
        LOAD_RI(ri, ssp, row0);
#pragma unroll
        for (int ai = 0; ai < 2; ++ai)
#pragma unroll
            for (int m = 0; m < 4; ++m) { __builtin_amdgcn_sched_barrier(0); const int row = row0 + ai * 128 + m * 16; float v[2][8]; ACC16B(v, acc, ai, m, ri[ai * 4 + m], b00, b01, b10, b11);
                float o[8];
#pragma unroll
                for (int e = 0; e < 8; ++e) o[e] = v[0][e] * __builtin_amdgcn_rcpf(1.0f + __expf(-v[0][e])) * v[1][e];
                __builtin_nontemporal_store(pack8(o), (u32x4*)(hid + ((size_t)(row >> 8) * (DFF / 64) + (col0 >> 6)) * (256 * 64) + (size_t)(row & 255) * 64 + (col0 & 63))); }
    }
};
#define RESID_ROW(q) (row0 + ((q) >> 2) * 128 + ((q) & 3) * 16)
template <bool INF32> struct ResidIn {
    u32x4 a, b;
    DI void load(const void* hin, size_t off) { if (INF32) { a = *(const u32x4*)((const float*)hin + off); b = *(const u32x4*)((const float*)hin + off + 4); } else a = *(const u32x4*)((const unsigned short*)hin + off); }
    DI void get(float (&v)[8]) const { if (INF32) { v[0] = __uint_as_float(a.x); v[1] = __uint_as_float(a.y); v[2] = __uint_as_float(a.z); v[3] = __uint_as_float(a.w); v[4] = __uint_as_float(b.x); v[5] = __uint_as_float(b.y); v[6] = __uint_as_float(b.z); v[7] = __uint_as_float(b.w); }
        else { v[0] = h_lo(a.x); v[1] = h_hi(a.x); v[2] = h_lo(a.y); v[3] = h_hi(a.y); v[4] = h_lo(a.z); v[5] = h_hi(a.z); v[6] = h_lo(a.w); v[7] = h_hi(a.w); } }
};
struct EpiResid {
    const unsigned short* hin; float* hout; const float* gate; float coef;
    DI void operator()(const AccT& acc, const Unit& u, int wr, int wc, int fr, int fq) const {
        const int row0 = u.pm * 256 + wr * 64 + fr, col0 = u.pn * 256 + wc * 32 + 8 * fq;
        const float* gp = gate + (size_t)((u.pm * 256) >> 13) * MODW + col0;
        f32x4 cg[2][2]; ResidIn<false> hv[2], hn[2];
#pragma unroll
        for (int bj = 0; bj < 2; ++bj)
#pragma unroll
            for (int n = 0; n < 2; ++n) { const f32x4 gt = *(const f32x4*)(gp + 128 * bj + 4 * n); cg[bj][n] = coef * (1.0f + gt); }
        hv[0].load(hin, (size_t)RESID_ROW(0) * DM + col0); hv[1].load(hin, (size_t)RESID_ROW(0) * DM + col0 + 128);
#pragma unroll
        for (int q = 0; q < 8; ++q) { __builtin_amdgcn_sched_barrier(0); const int ai = q >> 2, m = q & 3; const int row = RESID_ROW(q);
            if (q < 7) { hn[0].load(hin, (size_t)RESID_ROW(q + 1) * DM + col0); hn[1].load(hin, (size_t)RESID_ROW(q + 1) * DM + col0 + 128); }
#pragma unroll
            for (int bj = 0; bj < 2; ++bj) { float hvv[8]; hv[bj].get(hvv);
#pragma unroll
                for (int n = 0; n < 2; ++n) { f32x4 r;
#pragma unroll
                    for (int j = 0; j < 4; ++j) r[j] = fmaf(cg[bj][n][j], acc[ai][bj][m][n][j], hvv[4 * n + j]);
                    *(f32x4*)(hout + (size_t)row * DM + col0 + 128 * bj + 4 * n) = r; } }
            hv[0] = hn[0]; hv[1] = hn[1];
        }
    }
};
template <bool DUAL, bool INF32> struct EpiResidN {
    const void* hin; unsigned short* hout; const float* gate; float coef; float* ss; bf16_t* a1; const float* gs1; bf16_t* a2; const float* gs2;
    DI void operator()(const AccT& acc, const Unit& u, int wr, int wc, int fr, int fq) const {
        const int row0 = u.pm * 256 + wr * 64 + fr, col0 = u.pn * 256 + wc * 32 + 8 * fq; const int b = (u.pm * 256) >> 13;
        const float* gp = gate + (size_t)b * MODW + col0; const float* g1p = gs1 + b * DM + col0; const float* g2p = gs2 + b * DM + col0;
        f32x4 cg[2][2], ga[2][2]; ResidIn<INF32> hv[2], hn[2];
#pragma unroll
        for (int bj = 0; bj < 2; ++bj)
#pragma unroll
            for (int n = 0; n < 2; ++n) { const f32x4 gt = *(const f32x4*)(gp + 128 * bj + 4 * n); cg[bj][n] = coef * (1.0f + gt); ga[bj][n] = *(const f32x4*)(g1p + 128 * bj + 4 * n); }
        hv[0].load(hin, (size_t)RESID_ROW(0) * DM + col0); hv[1].load(hin, (size_t)RESID_ROW(0) * DM + col0 + 128);
#pragma unroll
        for (int q = 0; q < 8; ++q) { __builtin_amdgcn_sched_barrier(0); const int ai = q >> 2, m = q & 3; const int row = RESID_ROW(q); float ssr = 0.f;
            if (q < 7) { hn[0].load(hin, (size_t)RESID_ROW(q + 1) * DM + col0); hn[1].load(hin, (size_t)RESID_ROW(q + 1) * DM + col0 + 128); }
#pragma unroll
            for (int bj = 0; bj < 2; ++bj) { const int col = col0 + 128 * bj; float o1[8], o2[8], rr[8], hvv[8]; hv[bj].get(hvv);
#pragma unroll
                for (int n = 0; n < 2; ++n) { f32x4 gbv = {0.f, 0.f, 0.f, 0.f}; if (DUAL) gbv = *(const f32x4*)(g2p + 128 * bj + 4 * n);
#pragma unroll
                    for (int j = 0; j < 4; ++j) { const float r = fmaf(cg[bj][n][j], acc[ai][bj][m][n][j], hvv[4 * n + j]); rr[4 * n + j] = r; ssr = fmaf(r, r, ssr); o1[4 * n + j] = r * ga[bj][n][j]; if (DUAL) o2[4 * n + j] = r * gbv[j]; } }
                *(u32x4*)(hout + (size_t)row * DM + col) = (u32x4){pkh2(rr[0], rr[1]), pkh2(rr[2], rr[3]), pkh2(rr[4], rr[5]), pkh2(rr[6], rr[7])};
                *(u32x4*)(a1 + (size_t)row * DM + col) = pack8(o1);
                if (DUAL) *(u32x4*)(a2 + (size_t)row * DM + col) = pack8(o2); }
            ssr += __shfl_xor(ssr, 16, 64); ssr += __shfl_xor(ssr, 32, 64);
            if (fq == 0) unsafeAtomicAdd(ss + row, ssr);
            hv[0] = hn[0]; hv[1] = hn[1];
        }
    }
};
struct EpiQKV {
    bf16_t* dst; const float *qgain, *kgain, *cosT, *sinT; const float* ssp; const float* bias; int gofs;
    DI void operator()(const AccT& acc, const Unit& u, int wr, int wc, int fr, int fq) const {
        const int slot = 4 * u.pn + wc, type = slot >> 4; const int row0 = u.pm * 256 + wr * 64 + fr;
        const float* gain = type == 0 ? qgain : kgain;
        const float* bp = bias + (size_t)((u.pm * 256) >> 13) * 9216 + gofs + slot * 64 + 8 * fq; LOAD_B4(bp); LOAD_RI(ri, ssp, row0);
#pragma unroll
        for (int ai = 0; ai < 2; ++ai)
#pragma unroll
            for (int m = 0; m < 4; ++m) { __builtin_amdgcn_sched_barrier(0); const int row = row0 + ai * 128 + m * 16; float v[2][8]; ACC16B(v, acc, ai, m, ri[ai * 4 + m], b00, b01, b10, b11);
                if (type < 2) head_norm_rope(v, gain, true, row & (SEQ - 1), fq, cosT, sinT);
                bf16_t* rp = dst + (size_t)row * 3072 + slot * 64 + 8 * fq;
                *(u32x4*)(rp) = pack8(v[0]); *(u32x4*)(rp + 32) = pack8(v[1]); }
    }
};
struct EpiKV {
    bf16_t* dst; const float *kgain3, *cosT, *sinT; const float* ssp; const float* bias;
    DI void operator()(const AccT& acc, const Unit& u, int wr, int wc, int fr, int fq) const {
        const int slot = 4 * u.pn + wc, branch = slot >> 2, kv = (slot >> 1) & 1, kvh = slot & 1; const int row0 = u.pm * 256 + wr * 64 + fr;
        const bool nr = (kv == 0) && (branch > 0);
        const float* bp = bias + (size_t)((u.pm * 256) >> 13) * 768 + slot * 64 + 8 * fq; LOAD_B4(bp); LOAD_RI(ri, ssp, row0);
#pragma unroll
        for (int ai = 0; ai < 2; ++ai)
#pragma unroll
            for (int m = 0; m < 4; ++m) { __builtin_amdgcn_sched_barrier(0); const int row = row0 + ai * 128 + m * 16; float v[2][8]; ACC16B(v, acc, ai, m, ri[ai * 4 + m], b00, b01, b10, b11);
                if (nr) head_norm_rope(v, kgain3 + branch * 64, true, row & (SEQ - 1), fq, cosT, sinT);
                bf16_t* rp = dst + ((size_t)((((branch * 2 + kv) * 4 + (row >> 13)) * 2 + kvh)) * SEQ + (row & (SEQ - 1))) * 64 + 8 * fq;
                *(u32x4*)(rp) = pack8(v[0]); *(u32x4*)(rp + 32) = pack8(v[1]); }
    }
};
struct EpiCmp1 {
    bf16_t* hc; const float* bias;
    DI void operator()(const AccT& acc, const Unit& u, int wr, int wc, int fr, int fq) const {
        const int row0 = u.pm * 256 + wr * 64 + fr, col0 = wc * 32 + 8 * fq;
        const f32x4 b0 = *(const f32x4*)(bias + col0), b1 = *(const f32x4*)(bias + col0 + 4);
#pragma unroll
        for (int ai = 0; ai < 2; ++ai)
#pragma unroll
            for (int m = 0; m < 4; ++m) { __builtin_amdgcn_sched_barrier(0); const int row = row0 + ai * 128 + m * 16; float o[8];
#pragma unroll
                for (int n = 0; n < 2; ++n)
#pragma unroll
                    for (int j = 0; j < 4; ++j) { const float a = acc[ai][0][m][n][j] + (n ? b1[j] : b0[j]); o[4 * n + j] = a / (1.0f + __expf(-a)); }
                *(u32x4*)(hc + (size_t)row * 256 + col0) = pack8(o);
                *(u32x4*)(hc + (size_t)row * 256 + 128 + col0) = (u32x4){0u, 0u, 0u, 0u}; }
    }
};
template <bool NORM> struct EpiCmp2 {
    bf16_t* dst; const float* gain;
    DI void operator()(const AccT& acc, const Unit& u, int wr, int wc, int fr, int fq) const {
        if (wc != 0) return;
        const int row0 = u.pm * 256 + wr * 64 + fr;
#pragma unroll
        for (int ai = 0; ai < 2; ++ai)
#pragma unroll
            for (int m = 0; m < 4; ++m) { __builtin_amdgcn_sched_barrier(0); const int row = row0 + ai * 128 + m * 16; float v[2][8]; ACC16(v, acc, ai, m);
                if (NORM) head_norm_rope(v, gain, false, 0, fq, nullptr, nullptr);
                bf16_t* rp = dst + (size_t)row * 64 + 8 * fq;
                *(u32x4*)(rp) = pack8(v[0]); *(u32x4*)(rp + 32) = pack8(v[1]); }
    }
};
struct EpiQG {
    bf16_t *qn, *qr; float* gates; const float *qgain, *cosT, *sinT; const float* ssp; const float* bias;
    DI void operator()(const AccT& acc, const Unit& u, int wr, int wc, int fr, int fq) const {
        const int row0 = u.pm * 256 + wr * 64 + fr;
        if (u.pn < 4) {
            const int slot = 4 * u.pn + wc;
            const float* bp = bias + (size_t)((u.pm * 256) >> 13) * 1280 + slot * 64 + 8 * fq;
#pragma unroll
            for (int ai = 0; ai < 2; ++ai)
#pragma unroll
                for (int m = 0; m < 4; ++m) { __builtin_amdgcn_sched_barrier(0); const int row = row0 + ai * 128 + m * 16; float v[2][8]; const float rir = row_rinv(ssp, row); { LOAD_B4(bp); ACC16B(v, acc, ai, m, rir, b00, b01, b10, b11); }
                    head_norm_rope(v, qgain, false, 0, fq, nullptr, nullptr);
                    bf16_t* rp = qn + (size_t)row * DM + slot * 64 + 8 * fq;
                    *(u32x4*)(rp) = pack8(v[0]); *(u32x4*)(rp + 32) = pack8(v[1]);
                    const int pos = row & (SEQ - 1);
                    const f32x4 c0 = *(const f32x4*)(cosT + pos * 32 + 8 * fq), c1 = *(const f32x4*)(cosT + pos * 32 + 8 * fq + 4);
                    const f32x4 s0 = *(const f32x4*)(sinT + pos * 32 + 8 * fq), s1 = *(const f32x4*)(sinT + pos * 32 + 8 * fq + 4);
#pragma unroll
                    for (int e = 0; e < 8; ++e) { const float c = e < 4 ? c0[e & 3] : c1[e & 3], s = e < 4 ? s0[e & 3] : s1[e & 3];
                        const float x1 = v[0][e], x2 = v[1][e]; v[0][e] = x1 * c - x2 * s; v[1][e] = x1 * s + x2 * c; }
                    bf16_t* rq = qr + (size_t)row * DM + slot * 64 + 8 * fq;
                    *(u32x4*)(rq) = pack8(v[0]); *(u32x4*)(rq + 32) = pack8(v[1]); }
        } else {
            const int col0 = wc * 32 + 8 * fq;
            if (col0 < 48) {
                const float* bpg = bias + (size_t)((u.pm * 256) >> 13) * 1280 + 1024 + col0; const f32x4 bg0 = *(const f32x4*)(bpg), bg1 = *(const f32x4*)(bpg + 4);
#pragma unroll
                for (int ai = 0; ai < 2; ++ai)
#pragma unroll
                    for (int m = 0; m < 4; ++m) { __builtin_amdgcn_sched_barrier(0); const int row = row0 + ai * 128 + m * 16; const float rir = row_rinv(ssp, row);
#pragma unroll
                        for (int n = 0; n < 2; ++n) { f32x4 r; const f32x4 bb = n ? bg1 : bg0;
#pragma unroll
                            for (int j = 0; j < 4; ++j) r[j] = __builtin_amdgcn_rcpf(1.0f + __expf(-fmaf(acc[ai][0][m][n][j], rir, bb[j])));
                            *(f32x4*)(gates + (size_t)row * 48 + col0 + 4 * n) = r; } }
            }
        }
    }
};

DI int perm_col(int perm, int c) {
    const int hp = 64 * (4 * (c >> 8) + ((c & 127) >> 5)) + 32 * ((c & 255) >> 7) + (c & 31);
    if (perm == 0) return c;
    if (perm == 1) return hp;
    if (perm == 2) return ((c & 255) >> 7) * DFF + 128 * (c >> 8) + (c & 127);
    return c < 1024 ? hp : c;
}
DI void phase_prep(KP p, LAS unsigned char* lds, const int tid, const int bid, const int nblk) {
    float* modP = (float*)(p->ws + WS_MODP);
    {
        LAS float* ca = (LAS float*)lds;
        for (int i = tid; i < NB * DM; i += 512) { const float v = p->c[i]; ca[i] = v / (1.0f + __expf(-v)); }
        __syncthreads();
        for (int item = bid * 512 + tid; item < 16 * (MODW / 4); item += nblk * 512) {
            const int ks = item / (MODW / 4), col = (item % (MODW / 4)) * 4;
            const float* W; int ldw, cc;
            if (col < 18432) { const int l = col / 9216; cc = col % 9216; W = p->w_ada + (size_t)l * DM * 9216; ldw = 9216; } else { cc = col - 18432; W = p->w_ada_kv; ldw = 2048; }
            f32x4 a0 = {0.f, 0.f, 0.f, 0.f}, a1 = a0, a2 = a0, a3 = a0;
            for (int k = ks * 64; k < ks * 64 + 64; ++k) { const f32x4 w = *(const f32x4*)(W + (size_t)k * ldw + cc);
                a0 += ca[k] * w; a1 += ca[DM + k] * w; a2 += ca[2 * DM + k] * w; a3 += ca[3 * DM + k] * w; }
            *(f32x4*)(modP + (size_t)(ks * 4 + 0) * MODW + col) = a0; *(f32x4*)(modP + (size_t)(ks * 4 + 1) * MODW + col) = a1;
            *(f32x4*)(modP + (size_t)(ks * 4 + 2) * MODW + col) = a2; *(f32x4*)(modP + (size_t)(ks * 4 + 3) * MODW + col) = a3;
        }
        __syncthreads();
    }
    {
        float* cT = (float*)(p->ws + WS_ROPEC); float* sT = (float*)(p->ws + WS_ROPES);
        for (int idx = bid * 512 + tid; idx < SEQ * 32; idx += nblk * 512) {
            const int pos = idx >> 5, i = idx & 31;
            const float inv = exp2f(-(float)i * 0.41524101186092029f);
            const float ang = (float)pos * inv;
            const float n = rintf(ang * 0.63661977236758134f);
            float r = fmaf(-n, 1.57079637050628662109375f, ang); r = fmaf(-n, -4.37113900018624283e-8f, r);
            const float r2 = r * r;
            float sp = 2.7557319e-6f; sp = sp * r2 - 1.9841270e-4f; sp = sp * r2 + 8.3333333e-3f; sp = sp * r2 - 1.6666667e-1f;
            const float sn = r + r * r2 * sp;
            float cp = -2.7557319e-7f; cp = cp * r2 + 2.4801587e-5f; cp = cp * r2 - 1.3888889e-3f; cp = cp * r2 + 4.1666667e-2f; cp = cp * r2 - 0.5f;
            const float cs1 = 1.0f + r2 * cp;
            const int q = ((int)n) & 3;
            const float cs = (q == 0) ? cs1 : (q == 1) ? -sn : (q == 2) ? -cs1 : sn;
            const float ss = (q == 0) ? sn : (q == 1) ? cs1 : (q == 2) ? -sn : -cs1;
            cT[idx] = cs; sT[idx] = ss;
        }
    }
    {
        LAS float* red = (LAS float*)lds;
        float* bias1 = (float*)(p->ws + WS_BIAS1);
        for (int o = bid; o < 256; o += nblk) {
            const int which = o >> 7, n = o & 127; float s = 0.f;
            for (int j = 0; j < 4; ++j) { const int k = tid * 4 + j; s += p->cmp_pos[which * 2048 + k] * p->phi_w1[(size_t)which * 2048 * 128 + (size_t)k * 128 + n]; }
            s = wave_sum(s);
            __syncthreads();
            if ((tid & 63) == 0) red[tid >> 6] = s;
            __syncthreads();
            if (tid == 0) { float t = 0.f; for (int w = 0; w < 8; ++w) t += red[w]; bias1[o] = t; }
        }
        __syncthreads();
    }
    {
        LAS float* tile = (LAS float*)lds;
        for (int jn = 0; jn < NJOBS; ++jn) {
            Job jb; jb.src = p->jobs[jn].src; jb.dst = p->jobs[jn].dst; jb.nsrc = p->jobs[jn].nsrc; jb.ksrc = p->jobs[jn].ksrc; jb.kdst = p->jobs[jn].kdst; jb.ndst = p->jobs[jn].ndst; jb.perm = p->jobs[jn].perm;
            const int nkt = jb.kdst >> 6, nct = jb.ndst >> 7, ntile = nkt * nct;
            for (int t = bid; t < ntile; t += nblk) {
                const int c0 = (t / nkt) << 7, k0 = (t % nkt) << 6;
                { const int tx = tid & 31, ty = tid >> 5; const int L = perm_col(jb.perm, c0 + 4 * tx); const bool okc = L < jb.nsrc;
                    f32x4 v[4];
#pragma unroll
                    for (int i = 0; i < 4; ++i) { const int k = k0 + ty + 16 * i; v[i] = (f32x4){0.f, 0.f, 0.f, 0.f}; if (okc && k < jb.ksrc) v[i] = *(const f32x4*)(jb.src + (size_t)k * jb.nsrc + L); }
#pragma unroll
                    for (int i = 0; i < 4; ++i) { LAS float* tp = tile + (ty + 16 * i) * 129 + 4 * tx; tp[0] = v[i][0]; tp[1] = v[i][1]; tp[2] = v[i][2]; tp[3] = v[i][3]; } }
                __syncthreads();
                { const int cl = tid >> 2, kq = tid & 3; float o[16];
#pragma unroll
                    for (int i = 0; i < 16; ++i) o[i] = tile[(kq * 16 + i) * 129 + cl];
                    bf16_t* dp = jb.dst + (size_t)(c0 + cl) * jb.kdst + k0 + kq * 16;
                    *(u32x4*)(dp) = pack8(o); *(u32x4*)(dp + 8) = pack8(o + 8); }
                __syncthreads();
            }
        }
    }
}
DI void phase_modfinal(KP p, const int tid, const int bid, const int nblk) {
    const float* modP = (const float*)(p->ws + WS_MODP); float* modF = (float*)(p->ws + WS_MODF);
    for (int idx = bid * 512 + tid; idx < NB * MODW; idx += nblk * 512) {
        const int b = idx / MODW, col = idx % MODW;
        float s = col < 18432 ? p->b_ada[col] : p->b_ada_kv[col - 18432];
        for (int ks = 0; ks < 16; ++ks) s += modP[(size_t)(ks * 4 + b) * MODW + col];
        modF[idx] = s;
    }
}
DI void phase_bias(KP p, LAS unsigned char* lds, const int tid, const int bid, const int nblk) {
    const float* modF = (const float*)(p->ws + WS_MODF);
    float* gsv = (float*)(p->ws + WS_GS); float* bv = (float*)(p->ws + WS_BV);
    for (int idx = bid * 512 + tid; idx < 7 * 4 * DM; idx += nblk * 512) {
        const int s = idx >> 12, b = (idx >> 10) & 3, d = idx & 1023; const int t = s < 4 ? s : s - 1;
        const int off = s == 4 ? 18432 : t * 3072; const float g = s == 4 ? p->kv_norm_g[d] : p->norm_g[t * DM + d];
        gsv[idx] = g * (1.0f + modF[(size_t)b * MODW + off + 1024 + d]);
    }
    { float* ssz = (float*)(p->ws + WS_SSPA) + NTOK; for (int i = bid * 512 + tid; i < 6 * NTOK; i += nblk * 512) ssz[i] = 0.f; }
    LAS float* sh = (LAS float*)lds; LAS float* red = (LAS float*)(lds + 16384);
    for (int item = bid; item < 525; item += nblk) {
        const float* W; int N, s, bvoff, nout, i0;
        if (item < 352) { const int c = item / 88; i0 = c * 88; W = p->ffn_w_in + (size_t)c * DM * 5632; N = 5632; nout = 5632; bvoff = c * BV_FFN; s = c == 0 ? 0 : (c == 1 ? 2 : (c == 2 ? 3 : 6)); }
        else if (item < 496) { i0 = 352; W = p->a_w_qkv; N = 9216; nout = 9216; bvoff = BV_QKV; s = 1; }
        else if (item < 508) { i0 = 496; W = p->w_kv; N = 768; nout = 768; bvoff = BV_KV; s = 4; }
        else { i0 = 508; W = p->b_w_qg; N = 1072; nout = 1280; bvoff = BV_QG; s = 5; }
        const int off = s == 4 ? 18432 : (s < 4 ? s : s - 1) * 3072; const int col0 = (item - i0) * 64;
        for (int i = tid; i < 4 * DM; i += 512) sh[i] = modF[(size_t)(i >> 10) * MODW + off + (i & 1023)];
        __syncthreads();
        const int kc = tid >> 4, cg4 = tid & 15, col = col0 + 4 * cg4;
        f32x4 a0 = {0.f, 0.f, 0.f, 0.f}, a1 = a0, a2 = a0, a3 = a0;
        if (col < N) for (int k = kc * 32; k < kc * 32 + 32; ++k) { const f32x4 w = *(const f32x4*)(W + (size_t)k * N + col); a0 += sh[k] * w; a1 += sh[DM + k] * w; a2 += sh[2 * DM + k] * w; a3 += sh[3 * DM + k] * w; }
#pragma unroll
        for (int j = 0; j < 4; ++j) { red[(kc * 4 + 0) * 64 + cg4 * 4 + j] = a0[j]; red[(kc * 4 + 1) * 64 + cg4 * 4 + j] = a1[j]; red[(kc * 4 + 2) * 64 + cg4 * 4 + j] = a2[j]; red[(kc * 4 + 3) * 64 + cg4 * 4 + j] = a3[j]; }
        __syncthreads();
        if (tid < 256) { const int b = tid >> 6, cc = tid & 63; float t = 0.f; for (int q = 0; q < 32; ++q) t += red[(q * 4 + b) * 64 + cc];
            if (col0 + cc < N) bv[bvoff + b * nout + col0 + cc] = t; }
        __syncthreads();
    }
    {
        const int lane = tid & 63, wid = tid >> 6; bf16_t* out = (bf16_t*)(p->out); float* ssp = (float*)(p->ws + WS_SSPA); const float* x = p->x; const float* g1 = p->norm_g;
        for (int row = bid * 8 + wid; row < NTOK; row += nblk * 8) {
            const int b = row >> 13; const f32x4* hr = (const f32x4*)(x + (size_t)row * DM);
            f32x4 v[4]; float ss = 0.f;
#pragma unroll
            for (int i = 0; i < 4; ++i) { v[i] = hr[lane + 64 * i]; ss += v[i][0] * v[i][0] + v[i][1] * v[i][1] + v[i][2] * v[i][2] + v[i][3] * v[i][3]; }
            ss = wave_sum(ss);
#pragma unroll
            for (int i = 0; i < 4; ++i) { const int col = 4 * (lane + 64 * i);
                const f32x4 g = *(const f32x4*)(g1 + col), sc = *(const f32x4*)(modF + (size_t)b * MODW + 1024 + col);
                float y[4];
#pragma unroll
                for (int j = 0; j < 4; ++j) y[j] = v[i][j] * (g[j] * (1.0f + sc[j]));
                *(u32x2*)(out + (size_t)row * DM + col) = (u32x2){pk2(y[0], y[1]), pk2(y[2], y[3])}; }
            if (lane == 0) ssp[row] = ss;
        }
    }
}
DI void phase_normmod(const float* h, const float* g1, const float* mod1, bf16_t* out1, const float* g2, const float* mod2, bf16_t* out2, const int tid, const int bid, const int nblk) {
    const int lane = tid & 63, wid = tid >> 6;
    for (int row = bid * 8 + wid; row < NTOK; row += nblk * 8) {
        const int b = row >> 13; const f32x4* hr = (const f32x4*)(h + (size_t)row * DM);
        f32x4 v[4]; float ss = 0.f;
#pragma unroll
        for (int i = 0; i < 4; ++i) { v[i] = hr[lane + 64 * i]; ss += v[i][0] * v[i][0] + v[i][1] * v[i][1] + v[i][2] * v[i][2] + v[i][3] * v[i][3]; }
        ss = wave_sum(ss);
        const float rinv = rsqrtf(ss * (1.0f / DM) + EPSN);
#pragma unroll
        for (int i = 0; i < 4; ++i) { const int col = 4 * (lane + 64 * i);
            { const f32x4 g = *(const f32x4*)(g1 + col), sh = *(const f32x4*)(mod1 + (size_t)b * MODW + col), sc = *(const f32x4*)(mod1 + (size_t)b * MODW + 1024 + col);
              float y[4];
#pragma unroll
              for (int j = 0; j < 4; ++j) y[j] = v[i][j] * rinv * g[j] * (1.0f + sc[j]) + sh[j];
              *(u32x2*)(out1 + (size_t)row * DM + col) = (u32x2){pk2(y[0], y[1]), pk2(y[2], y[3])}; }
            if (out2) { const f32x4 g = *(const f32x4*)(g2 + col), sh = *(const f32x4*)(mod2 + (size_t)b * MODW + col), sc = *(const f32x4*)(mod2 + (size_t)b * MODW + 1024 + col);
              float y[4];
#pragma unroll
              for (int j = 0; j < 4; ++j) y[j] = v[i][j] * rinv * g[j] * (1.0f + sc[j]) + sh[j];
              *(u32x2*)(out2 + (size_t)row * DM + col) = (u32x2){pk2(y[0], y[1]), pk2(y[2], y[3])}; }
        }
    }
}

constexpr int ROWB = 144;
#define MFMA32(a, b, c) __builtin_amdgcn_mfma_f32_32x32x16_bf16((a), (b), (c), 0, 0, 0)
DI f32x16 qk_tile(const LAS unsigned char* Kt, const bf16x8 (&Qb)[4], int r, int h) {
    f32x16 st;
#pragma unroll
    for (int i = 0; i < 16; ++i) st[i] = 0.f;
#pragma unroll
    for (int ks = 0; ks < 4; ++ks) { const bf16x8 kf = *(const LAS bf16x8*)(Kt + r * ROWB + (16 * ks + 8 * h) * 2); st = MFMA32(kf, Qb[ks], st); }
    return st;
}
DI void pv_tile(const LAS unsigned char* Vt, const float (&pv)[16], f32x16 (&o)[2], int lane) {
    const int h = lane >> 5, dg = (lane >> 4) & 1, i16 = lane & 15;
    const LAS unsigned char* vb = Vt + (4 * h + (i16 >> 2)) * ROWB + (16 * dg + 4 * (i16 & 3)) * 2;
#pragma unroll
    for (int s = 0; s < 2; ++s) {
        u32x4 pw; pw.x = pk2(pv[8 * s], pv[8 * s + 1]); pw.y = pk2(pv[8 * s + 2], pv[8 * s + 3]); pw.z = pk2(pv[8 * s + 4], pv[8 * s + 5]); pw.w = pk2(pv[8 * s + 6], pv[8 * s + 7]);
        const bf16x8 pf = __builtin_bit_cast(bf16x8, pw);
#pragma unroll
        for (int mt = 0; mt < 2; ++mt) {
            const s16x4 lo = __builtin_amdgcn_ds_read_tr16_b64_v4i16((LAS s16x4*)(vb + (16 * s) * ROWB + mt * 64));
            const s16x4 hi = __builtin_amdgcn_ds_read_tr16_b64_v4i16((LAS s16x4*)(vb + (16 * s + 8) * ROWB + mt * 64));
            const bf16x8 vf = __builtin_shufflevector(lo, hi, 0, 1, 2, 3, 4, 5, 6, 7);
            o[mt] = MFMA32(vf, pf, o[mt]);
        }
    }
}
template <bool MASKED>
DI void softmax_fx(const f32x16& st, unsigned vmask, float bias, float& lsum, float (&pv)[16]) {
    float ps = 0.f;
#pragma unroll
    for (int i = 0; i < 16; ++i) { float s = fmaf(st[i], SC2, bias); if (MASKED) s = ((vmask >> i) & 1u) ? s : -1e30f; const float pe = __builtin_amdgcn_exp2f(s); pv[i] = pe; ps += pe; }
    lsum += ps;
}
DI float softmax_shift(const float* gq, const float* gk, int lane) {
    float a = fabsf(gq[lane]), b = fabsf(gk[lane]);
    for (int o = 32; o >= 1; o >>= 1) { a = fmaxf(a, __shfl_xor(a, o, 64)); b = fmaxf(b, __shfl_xor(b, o, 64)); }
    return fmaxf(0.f, 64.0f * SC2 * a * b - 60.0f);
}

DI void qk_pair(const LAS unsigned char* Kt, const bf16x8 (&Qb)[4], int r, int h, f32x16& s0, f32x16& s1) {
#pragma unroll
    for (int i = 0; i < 16; ++i) { s0[i] = 0.f; s1[i] = 0.f; }
#pragma unroll
    for (int ks = 0; ks < 4; ++ks) { const bf16x8 k0 = *(const LAS bf16x8*)(Kt + r * ROWB + (16 * ks + 8 * h) * 2), k1 = *(const LAS bf16x8*)(Kt + (32 + r) * ROWB + (16 * ks + 8 * h) * 2);
        s0 = MFMA32(k0, Qb[ks], s0); s1 = MFMA32(k1, Qb[ks], s1); }
}
DI void pv_pair(const LAS unsigned char* Vt, const float (&p0)[16], const float (&p1)[16], f32x16 (&o)[2], int lane) {
    pv_tile(Vt, p0, o, lane); pv_tile(Vt + 32 * ROWB, p1, o, lane);
}
DI void phase_dilated(KP p, LAS unsigned char* lds, int g, const int tid, const int bid, const int nblk) {
    const int R = g == 0 ? 1 : (g == 1 ? 4 : 16), nqb = (SEQ / R) / 256, nunits = NB * R * 16 * nqb;
    const bf16_t* qkv = (const bf16_t*)(p->ws + WS_QKVG); bf16_t* oacc = (bf16_t*)(p->ws + WS_OACC); float* lse = (float*)(p->ws + WS_LSE);
    const int lane = tid & 63, wid = tid >> 6, r = lane & 31, h = lane >> 5;
    LAS unsigned char* Ks = lds; LAS unsigned char* Vs = lds + 384 * ROWB; LAS unsigned char* Qs = lds + 768 * ROWB;
    const float shift = softmax_shift(p->a_q_gain + g * 64, p->a_k_gain + g * 64, lane);
    u32x4 rg[16];
    auto load_unit = [&](int un) {
        const int qb_ = un % nqb; int tmp_ = un / nqb; const int hd_ = tmp_ % 16; tmp_ /= 16; const int res_ = tmp_ % R, b_ = tmp_ / R;
        const int Q0_ = qb_ * 256, kbase_ = Q0_ - 128;
#pragma unroll
        for (int j = 0; j < 16; ++j) { const int idx = tid + 512 * j;
            const int row = idx >> 3, ch = idx & 7; const int which = row < 384 ? 0 : (row < 768 ? 1 : 2);
            const int lr = row - (which == 0 ? 0 : (which == 1 ? 384 : 768));
            const int mm = which < 2 ? kbase_ + lr : Q0_ + lr;
            u32x4 val = {0u, 0u, 0u, 0u};
            if (mm >= 0) { const size_t tok = (size_t)b_ * SEQ + (size_t)mm * R + res_; const int col = (which == 0 ? 1024 : (which == 1 ? 2048 : 0)) + hd_ * 64 + ch * 8;
                val = *(const u32x4*)(qkv + tok * 3072 + col); }
            rg[j] = val; }
    };
    const bool swz = ((nblk & 7) == 0) && (nunits % nblk == 0);
    const int nit = (nunits + nblk - 1) / nblk;
    auto unit_of = [&](int i) { return swz ? (bid & 7) * (nunits >> 3) + i * (nblk >> 3) + (bid >> 3) : i * nblk + bid; };
    if (unit_of(0) < nunits) load_unit(unit_of(0));
    for (int it = 0; it < nit; ++it) {
        const int unit = unit_of(it); if (unit >= nunits) break;
        const int qb = unit % nqb; int tmp = unit / nqb; const int hd = tmp % 16; tmp /= 16; const int res = tmp % R, b = tmp / R;
        const int Q0 = qb * 256, kbase = Q0 - 128;
#pragma unroll
        for (int j = 0; j < 16; ++j) { const int idx = tid + 512 * j; *(LAS u32x4*)(lds + (idx >> 3) * ROWB + (idx & 7) * 16) = rg[j]; }
        __syncthreads();
        if (it + 1 < nit && unit_of(it + 1) < nunits) load_unit(unit_of(it + 1));
        bf16x8 Qb[4];
#pragma unroll
        for (int ks = 0; ks < 4; ++ks) Qb[ks] = *(const LAS bf16x8*)(Qs + (32 * wid + r) * ROWB + (16 * ks + 8 * h) * 2);
        float lsum = 0.f; f32x16 o[2];
#pragma unroll
        for (int i = 0; i < 16; ++i) { o[0][i] = 0.f; o[1][i] = 0.f; }
        const int qm = Q0 + 32 * wid + r;
        for (int tt = 0; tt < 5; ++tt) {
            const int jt = wid + tt; const int k0 = kbase + 32 * jt;
            if (k0 + 31 < 0) continue;
            const f32x16 st = qk_tile(Ks + jt * 32 * ROWB, Qb, r, h);
            float pv[16];
            if (tt == 0 || tt == 4) {
                unsigned vmask = 0u;
#pragma unroll
                for (int i = 0; i < 16; ++i) { const int km = k0 + crow(i, h); const bool ok = (km <= qm) && (qm - km <= 128); vmask |= ok ? (1u << i) : 0u; }
                softmax_fx<true>(st, vmask, -shift, lsum, pv);
            } else softmax_fx<false>(st, 0u, -shift, lsum, pv);
            pv_tile(Vs + jt * 32 * ROWB, pv, o, lane);
        }
        const float ltot = lsum + __shfl_xor(lsum, 32, 64);
        const float inv = 1.0f / ltot; const float lse_cur = (shift + log2f(ltot)) * LN2;
        const size_t tok = (size_t)b * SEQ + (size_t)qm * R + res;
        float wp = 0.f, wc2 = 1.f, lse_new = lse_cur;
        if (g > 0) { const float lp = lse[tok * 16 + hd]; const float mxl = fmaxf(lp, lse_cur); lse_new = mxl + logf(__expf(lp - mxl) + __expf(lse_cur - mxl)); wp = __expf(lp - lse_new); wc2 = __expf(lse_cur - lse_new); }
        bf16_t* op = oacc + tok * DM + hd * 64;
#pragma unroll
        for (int mt = 0; mt < 2; ++mt)
#pragma unroll
            for (int ig = 0; ig < 4; ++ig) { const int d0 = 32 * mt + 8 * ig + 4 * h;
                float v0 = o[mt][4 * ig] * inv * wc2, v1 = o[mt][4 * ig + 1] * inv * wc2, v2 = o[mt][4 * ig + 2] * inv * wc2, v3 = o[mt][4 * ig + 3] * inv * wc2;
                if (g > 0) { const u32x2 pr = *(const u32x2*)(op + d0); v0 += wp * bf_lo(pr.x); v1 += wp * bf_hi(pr.x); v2 += wp * bf_lo(pr.y); v3 += wp * bf_hi(pr.y); }
                *(u32x2*)(op + d0) = (u32x2){pk2(v0, v1), pk2(v2, v3)}; }
        if (h == 0) lse[tok * 16 + hd] = lse_new;
        __syncthreads();
    }
}

constexpr int NSA_KVBUF = 2 * 128 * ROWB;
constexpr int NSA_PSUM = 2 * NSA_KVBUF;
constexpr int NSA_IMP = NSA_PSUM + 8 * 4 * 512 * 4;
constexpr int NSA_SEL = NSA_IMP + 8 * 128 * 4;
template <int CH, bool WHOLE = false, class F>
DI void stream_keys(const int tid, const bf16_t* Kg, const bf16_t* Vg, int key_lo, int nch, LAS unsigned char* lds, F&& fn) {
    constexpr int BUF = 2 * CH * ROWB, NBLK = 2 * CH * 9 / 64, NIT = (NBLK + 7) / 8;
    const int wid = __builtin_amdgcn_readfirstlane(tid >> 6), lane = tid & 63;
    auto issue = [&](int c, LAS unsigned char* buf) {
#pragma unroll
        for (int i = 0; i < NIT; ++i) { const int blk = i * 8 + wid;
            if (blk < NBLK) { const int L = blk * 64 + lane; const bool isv = blk >= NBLK / 2; const int Lr = L - (isv ? CH * 9 : 0); const int row = Lr / 9, ch = Lr - row * 9;
                const bf16_t* srcp = (isv ? Vg : Kg) + (size_t)(key_lo + c * CH + row) * 64 + (ch == 8 ? 0 : ch) * 8;
                __builtin_amdgcn_global_load_lds((const unsigned*)srcp, (LAS unsigned*)(buf + blk * 1024), 16, 0, 0); } }
    };
    issue(0, lds);
    for (int c = 0; c < nch; ++c) {
        LAS unsigned char* buf = lds + (c & 1) * BUF;
        asm volatile("s_waitcnt vmcnt(0)" ::: "memory");
        __syncthreads();
        if (c + 1 < nch) issue(c + 1, lds + ((c + 1) & 1) * BUF);
        if (WHOLE) fn(key_lo + c * CH, buf, buf + CH * ROWB);
        else {
#pragma unroll 1
        for (int t2 = 0; t2 < CH / 64; ++t2) fn(key_lo + c * CH + t2 * 64, buf + t2 * 64 * ROWB, buf + CH * ROWB + t2 * 64 * ROWB); }
    }
    __syncthreads();
}
DI void load_q(bf16x8 (&Qb)[4], const bf16_t* q, size_t tok, int head, int h) {
#pragma unroll
    for (int ks = 0; ks < 4; ++ks) Qb[ks] = *(const bf16x8*)(q + tok * DM + head * 64 + 16 * ks + 8 * h);
}
DI void phase_nsa(KP p, LAS unsigned char* lds, const int tid, const int bid, const int nblk) {
    const bf16_t* kvb = (const bf16_t*)(p->ws + WS_KV); const bf16_t* cmpb = (const bf16_t*)(p->ws + WS_CMP);
    const bf16_t* qn = (const bf16_t*)(p->ws + WS_QN); const bf16_t* qr = (const bf16_t*)(p->ws + WS_QR);
    const float* gates = (const float*)(p->ws + WS_GATES); bf16_t* outp = (bf16_t*)(p->ws + WS_UKV);
    const int lane = tid & 63, wid = tid >> 6, r = lane & 31, h = lane >> 5, ql = r >> 3, hl = r & 7;
    LAS float* psw = (LAS float*)(lds + NSA_PSUM + wid * 4 * 512 * 4);
    LAS float* impw = (LAS float*)(lds + NSA_IMP + wid * 128 * 4);
    LAS unsigned long long* selw = (LAS unsigned long long*)(lds + NSA_SEL + wid * 64);
    const int nunits = NB * 2 * (SEQ / 32);
    const float shc = __int_as_float(__builtin_amdgcn_readfirstlane(__float_as_int(softmax_shift(p->b_q_gain, p->kv_k_gain, lane))));
    const float shs = __int_as_float(__builtin_amdgcn_readfirstlane(__float_as_int(softmax_shift(p->b_q_gain, p->kv_k_gain + 64, lane))));
    const float shw = __int_as_float(__builtin_amdgcn_readfirstlane(__float_as_int(softmax_shift(p->b_q_gain, p->kv_k_gain + 128, lane))));
    for (int it = 0; it * nblk < nunits; ++it) {
        const int bi = (it & 1) ? (nblk - 1 - bid) : bid;
        const int unit = it * nblk + bi;
        if (unit >= nunits) continue;
        const int qb = unit >> 3, b = (unit >> 1) & 3, kvh = unit & 1;
        const int t0 = qb * 32, tw = t0 + 4 * wid, t = tw + ql;
        const size_t tok = (size_t)b * SEQ + t; const int head = kvh * 8 + hl;
        bf16x8 Qb[4];
        {
            load_q(Qb, qn, tok, head, h);
            const bf16_t* Kc = cmpb + (size_t)(b * 2 + kvh) * 512 * 64; const bf16_t* Vc = cmpb + (size_t)4096 * 64 + (size_t)(b * 2 + kvh) * 512 * 64;
            const int ncv = t0 / 16 + 1 > 511 ? 511 : t0 / 16 + 1; const int nch = (ncv + 127) / 128;
            for (int i = lane; i < 4 * 512; i += 64) psw[i] = 0.f;
            float lsum = 0.f;
            stream_keys<128>(tid, Kc, Vc, 0, nch, lds, [&](int k0, const LAS unsigned char* Kt, const LAS unsigned char* Vt) {
                if (k0 * 16 + 31 > tw + 3) return;
                f32x16 s0, s1; qk_pair(Kt, Qb, r, h, s0, s1);
                unsigned vm0 = 0u, vm1 = 0u;
#pragma unroll
                for (int i = 0; i < 16; ++i) { const int c = k0 + crow(i, h); vm0 |= (c * 16 + 31 <= t) ? (1u << i) : 0u; vm1 |= ((c + 32) * 16 + 31 <= t) ? (1u << i) : 0u; }
                float pv[16];
                softmax_fx<true>(s0, vm0, -shc, lsum, pv); softmax_fx<true>(s1, vm1, -shc, lsum, pv);
            });
            const float ltot = lsum + __shfl_xor(lsum, 32, 64);
            const float linv = 1.0f / fmaxf(ltot, 1e-30f);
            f32x16 o[2];
#pragma unroll
            for (int i = 0; i < 16; ++i) { o[0][i] = 0.f; o[1][i] = 0.f; }
            stream_keys<128>(tid, Kc, Vc, 0, nch, lds, [&](int k0, const LAS unsigned char* Kt, const LAS unsigned char* Vt) {
                if (k0 * 16 + 31 > tw + 3) return;
                f32x16 s0, s1; qk_pair(Kt, Qb, r, h, s0, s1);
                float p0[16], p1[16];
#pragma unroll
                for (int i = 0; i < 16; ++i) { const int c = k0 + crow(i, h);
                    p0[i] = (c * 16 + 31 <= t) ? __builtin_amdgcn_exp2f(fmaf(s0[i], SC2, -shc)) * linv : 0.f;
                    p1[i] = ((c + 32) * 16 + 31 <= t) ? __builtin_amdgcn_exp2f(fmaf(s1[i], SC2, -shc)) * linv : 0.f; }
#pragma unroll
                for (int i = 0; i < 16; ++i) { const float a = sum8(p0[i]), b = sum8(p1[i]);
                    if (hl == 0) { psw[ql * 512 + k0 + crow(i, h)] = a; psw[ql * 512 + k0 + 32 + crow(i, h)] = b; } }
                pv_pair(Vt, p0, p1, o, lane);
            });
            const float g0 = gates[tok * 48 + head];
            LAS float* stash = (LAS float*)(lds + wid * 8192);
#pragma unroll
            for (int i = 0; i < 16; ++i) { stash[i * 64 + lane] = g0 * o[0][i]; stash[(16 + i) * 64 + lane] = g0 * o[1][i]; }
        }
        __builtin_amdgcn_wave_barrier();
        unsigned long long sello = 0ull, selhi = 0ull;
        for (int q4 = 0; q4 < 4; ++q4) {
            const int tq = tw + q4, jtq = tq >> 6;
            unsigned key[2]; bool cand[2], fsel[2];
#pragma unroll
            for (int e = 0; e < 2; ++e) { const int jj = lane + 64 * e, c4 = 4 * jj; const LAS float* P = psw + q4 * 512;
                float im = (c4 > 0) ? P[c4 - 1] : 0.f; im = im + 2.0f * P[c4]; im = im + 2.0f * P[c4 + 1]; im = im + 2.0f * P[c4 + 2]; im = im + P[c4 + 3];
                const bool forced = (jj == 0) || (jj == jtq) || (jj == jtq - 1); const bool valid = jj <= jtq;
                fsel[e] = forced && valid; cand[e] = valid && !forced; key[e] = cand[e] ? __float_as_uint(im) : 0u; }
            int remaining = 16 - (int)__popcll(__ballot(fsel[0])) - (int)__popcll(__ballot(fsel[1]));
            unsigned prefix = 0u;
#pragma unroll 1
            for (int bit = 30; bit >= 0; --bit) {
                const unsigned test = prefix | (1u << bit), himask = ~((1u << bit) - 1u);
                const int c = (int)__popcll(__ballot(cand[0] && ((key[0] & himask) == test))) + (int)__popcll(__ballot(cand[1] && ((key[1] & himask) == test)));
                if (c >= remaining) prefix = test; else remaining -= c;
            }
            const bool eq0 = cand[0] && key[0] == prefix, eq1 = cand[1] && key[1] == prefix;
            const unsigned long long beq0 = __ballot(eq0), beq1 = __ballot(eq1), ltm = (1ull << lane) - 1ull;
            const int rank0 = (int)__popcll(beq0 & ltm), rank1 = (int)__popcll(beq0) + (int)__popcll(beq1 & ltm);
            const bool sel0 = fsel[0] || (cand[0] && key[0] > prefix) || (eq0 && rank0 < remaining), sel1 = fsel[1] || (cand[1] && key[1] > prefix) || (eq1 && rank1 < remaining);
            const unsigned long long blo = __ballot(sel0), bhi = __ballot(sel1);
            if (ql == q4) { sello = blo; selhi = bhi; }
        }
        (void)impw;
        (void)selw;
        { LAS float* stash = (LAS float*)(lds + wid * 8192);
#pragma unroll
          for (int i = 0; i < 32; ++i) psw[i * 64 + lane] = stash[i * 64 + lane]; }
        __syncthreads();
        load_q(Qb, qr, tok, head, h);
        {
            const bf16_t* Kg = kvb + (size_t)((((1 * 2 + 0) * 4 + b) * 2 + kvh)) * SEQ * 64; const bf16_t* Vg = kvb + (size_t)((((1 * 2 + 1) * 4 + b) * 2 + kvh)) * SEQ * 64;
            const int nch = (t0 + 32 + 127) / 128;
            float lsum = 0.f; f32x16 o[2];
#pragma unroll
            for (int i = 0; i < 16; ++i) { o[0][i] = 0.f; o[1][i] = 0.f; }
            stream_keys<128, true>(tid, Kg, Vg, 0, nch, lds, [&](int k0, const LAS unsigned char* Kt, const LAS unsigned char* Vt) {
                if (k0 > tw + 3) return;
                const int bj = k0 >> 6;
                const bool selx = ((bj < 64 ? (sello >> bj) : (selhi >> (bj - 64))) & 1ull) != 0ull, sely = ((bj < 64 ? (sello >> (bj + 1)) : (selhi >> (bj - 63))) & 1ull) != 0ull;
                const bool anyx = __ballot(selx) != 0ull, anyy = (k0 + 64 <= tw + 3) && (__ballot(sely) != 0ull);
                if (anyx && anyy) {
                    f32x16 s0, s1, s2, s3; qk_pair(Kt, Qb, r, h, s0, s1); qk_pair(Kt + 64 * ROWB, Qb, r, h, s2, s3);
                    float p0[16], p1[16], p2[16], p3[16];
                    const float bx = selx ? -shs : -1e30f, by = sely ? -shs : -1e30f;
                    if (k0 + 127 > tw) {
                        unsigned vm0 = 0u, vm1 = 0u, vm2 = 0u, vm3 = 0u;
#pragma unroll
                        for (int i = 0; i < 16; ++i) { const int kp = k0 + crow(i, h); vm0 |= (kp <= t) ? (1u << i) : 0u; vm1 |= (kp + 32 <= t) ? (1u << i) : 0u; vm2 |= (kp + 64 <= t) ? (1u << i) : 0u; vm3 |= (kp + 96 <= t) ? (1u << i) : 0u; }
                        softmax_fx<true>(s0, vm0, bx, lsum, p0); softmax_fx<true>(s1, vm1, bx, lsum, p1); softmax_fx<true>(s2, vm2, by, lsum, p2); softmax_fx<true>(s3, vm3, by, lsum, p3);
                    } else { softmax_fx<false>(s0, 0u, bx, lsum, p0); softmax_fx<false>(s1, 0u, bx, lsum, p1); softmax_fx<false>(s2, 0u, by, lsum, p2); softmax_fx<false>(s3, 0u, by, lsum, p3); }
                    pv_pair(Vt, p0, p1, o, lane); pv_pair(Vt + 64 * ROWB, p2, p3, o, lane);
                } else if (anyx || anyy) {
                    const int off = anyx ? 0 : 64; const int kk = k0 + off; const bool sel = anyx ? selx : sely;
                    f32x16 s0, s1; qk_pair(Kt + off * ROWB, Qb, r, h, s0, s1);
                    float p0[16], p1[16];
                    const float bias = sel ? -shs : -1e30f;
                    if (kk + 63 > tw) {
                        unsigned vm0 = 0u, vm1 = 0u;
#pragma unroll
                        for (int i = 0; i < 16; ++i) { const int kp = kk + crow(i, h); vm0 |= (kp <= t) ? (1u << i) : 0u; vm1 |= (kp + 32 <= t) ? (1u << i) : 0u; }
                        softmax_fx<true>(s0, vm0, bias, lsum, p0); softmax_fx<true>(s1, vm1, bias, lsum, p1);
                    } else { softmax_fx<false>(s0, 0u, bias, lsum, p0); softmax_fx<false>(s1, 0u, bias, lsum, p1); }
                    pv_pair(Vt + off * ROWB, p0, p1, o, lane);
                }
            });
            const float ltot = lsum + __shfl_xor(lsum, 32, 64);
            const float sc = gates[tok * 48 + 16 + head] / fmaxf(ltot, 1e-30f);
#pragma unroll
            for (int i = 0; i < 16; ++i) { psw[i * 64 + lane] += sc * o[0][i]; psw[(16 + i) * 64 + lane] += sc * o[1][i]; }
        }
        {
            const bf16_t* Kg = kvb + (size_t)((((2 * 2 + 0) * 4 + b) * 2 + kvh)) * SEQ * 64; const bf16_t* Vg = kvb + (size_t)((((2 * 2 + 1) * 4 + b) * 2 + kvh)) * SEQ * 64;
            const int lo = t0 - 511 < 0 ? 0 : ((t0 - 511) & ~127); const int nch = (t0 + 32 - lo + 127) / 128;
            float lsum = 0.f; f32x16 o[2];
#pragma unroll
            for (int i = 0; i < 16; ++i) { o[0][i] = 0.f; o[1][i] = 0.f; }
            stream_keys<128>(tid, Kg, Vg, lo, nch, lds, [&](int k0, const LAS unsigned char* Kt, const LAS unsigned char* Vt) {
                if (k0 > tw + 3 || k0 + 63 < tw - 511) return;
                f32x16 s0, s1; qk_pair(Kt, Qb, r, h, s0, s1);
                float p0[16], p1[16];
                if (k0 + 63 > tw || k0 < tw + 3 - 511) {
                    unsigned vm0 = 0u, vm1 = 0u;
#pragma unroll
                    for (int i = 0; i < 16; ++i) { const int kp = k0 + crow(i, h); vm0 |= (kp <= t && t - kp < 512) ? (1u << i) : 0u; vm1 |= (kp + 32 <= t && t - kp - 32 < 512) ? (1u << i) : 0u; }
                    softmax_fx<true>(s0, vm0, -shw, lsum, p0); softmax_fx<true>(s1, vm1, -shw, lsum, p1);
                } else { softmax_fx<false>(s0, 0u, -shw, lsum, p0); softmax_fx<false>(s1, 0u, -shw, lsum, p1); }
                pv_pair(Vt, p0, p1, o, lane);
            });
            const float ltot = lsum + __shfl_xor(lsum, 32, 64);
            const float sc = gates[tok * 48 + 32 + head] / fmaxf(ltot, 1e-30f);
            bf16_t* op = outp + tok * DM + head * 64;
#pragma unroll
            for (int mt = 0; mt < 2; ++mt)
#pragma unroll
                for (int ig = 0; ig < 4; ++ig) { const int d0 = 32 * mt + 8 * ig + 4 * h; float w[4];
#pragma unroll
                    for (int j = 0; j < 4; ++j) w[j] = psw[(mt * 16 + 4 * ig + j) * 64 + lane] + sc * o[mt][4 * ig + j];
                    *(u32x2*)(op + d0) = (u32x2){pk2(w[0], w[1]), pk2(w[2], w[3])}; }
        }
    }
}


#define XB_TMO      128
#define XB_XCNT(j)  (256  + 64 * (j))
#define XB_XSUB(j)  (1280 + 64 * (j))
#define XB_XGEN(j)  (2304 + 64 * (j))
#define XB_TOP      3328
#define XB_TOPGEN   3392
#define XCD_BAR_WORDS 3456
#define XB_SPIN_CAP (1u << 18)
DI unsigned xb_ld(unsigned* p)              { return __hip_atomic_load(p, __ATOMIC_RELAXED, __HIP_MEMORY_SCOPE_AGENT); }
DI unsigned xb_add(unsigned* p, unsigned v) { return __hip_atomic_fetch_add(p, v, __ATOMIC_RELAXED, __HIP_MEMORY_SCOPE_AGENT); }
DI unsigned xb_xcc_id() { return (unsigned)__builtin_amdgcn_s_getreg((3 << 11) | 20) & 0xFu; }
#define XB_SPIN(cond, bar) do { unsigned _sp = 0; while (cond) { __builtin_amdgcn_s_sleep(1); \
    if ((++_sp & 255u) == 0u) { if (xb_ld(&(bar)[XB_TMO])) break; if (_sp > XB_SPIN_CAP) { atomicAdd(&(bar)[XB_TMO], 1u); break; } } } } while (0)
struct XcdBarrier { unsigned* bar; unsigned x; volatile LAS unsigned* st; };
DI XcdBarrier xcd_barrier_post(unsigned* bar, volatile LAS unsigned* st) {
    XcdBarrier b; b.bar = bar; b.x = xb_xcc_id(); b.st = st;
    if (threadIdx.x == 0) (void)xb_add(&bar[XB_XCNT(b.x)], 1u);
    return b;
}
DI void xcd_barrier_complete(unsigned* bar, unsigned x, unsigned& nloc, unsigned& nx) {
    const unsigned G = gridDim.x * gridDim.y * gridDim.z;
    unsigned sum, cnt, mine, sp = 0u;
    for (;;) {
        sum = 0u; cnt = 0u; mine = 0u;
#pragma unroll
        for (unsigned j = 0; j < 16; ++j) { const unsigned c = xb_ld(&bar[XB_XCNT(j)]); sum += c; cnt += (c > 0u) ? 1u : 0u; mine = (j == x) ? c : mine; }
        if (sum == G) break;
        __builtin_amdgcn_s_sleep(1);
        if ((++sp & 255u) == 0u) { if (xb_ld(&bar[XB_TMO])) break; if (sp > XB_SPIN_CAP) { atomicAdd(&bar[XB_TMO], 1u); break; } }
    }
    nloc = mine > 0u ? mine : 1u; nx = cnt > 0u ? cnt : 1u;
}
DI void xcd_barrier(const XcdBarrier& b, const int tid) {
    asm volatile("s_waitcnt vmcnt(0)" ::: "memory");
    __syncthreads();
    if (tid == 0) {
        unsigned* bar = b.bar;
        __builtin_amdgcn_s_waitcnt(0);
        unsigned nloc = b.st[0], nx = b.st[1];
        if (nloc == 0u) { xcd_barrier_complete(bar, b.x, nloc, nx); b.st[0] = nloc; b.st[1] = nx; }
        const unsigned old = xb_add(&bar[XB_XSUB(b.x)], 1u);
        const unsigned gen = old / nloc;
        if (old + 1u == (gen + 1u) * nloc) {
            __builtin_amdgcn_fence(__ATOMIC_RELEASE, "agent");
            asm volatile("s_waitcnt vmcnt(0)" ::: "memory");
            const unsigned og = xb_add(&bar[XB_TOP], 1u);
            const unsigned tg = og / nx;
            if (og + 1u == (tg + 1u) * nx) xb_add(&bar[XB_TOPGEN], 1u);
            else XB_SPIN(xb_ld(&bar[XB_TOPGEN]) == tg, bar);
            __builtin_amdgcn_fence(__ATOMIC_ACQUIRE, "agent");
            xb_add(&bar[XB_XGEN(b.x)], 1u);
            asm volatile("s_waitcnt vmcnt(0)" ::: "memory");
        } else {
            XB_SPIN(xb_ld(&bar[XB_XGEN(b.x)]) == gen, bar);
            __builtin_amdgcn_fence(__ATOMIC_ACQUIRE, "agent");
            asm volatile("s_waitcnt vmcnt(0)" ::: "memory");
        }
    }
    __syncthreads();
}

DI const float* modp(KP p, int l, int sub, int which) { return (const float*)(p->ws + WS_MODF) + l * 9216 + sub * 3072 + which * 1024; }
template <class Epi>
DI void run_gemm(const int tid, LAS unsigned char* lds, const bf16_t* A, int lda, const bf16_t* Bt, int ldb, int M, int N, int K, const Epi& E, int G, int c) {
    int Kv = K; asm volatile("" : "+s"(Kv));
    pg8::Gemm g; g.A = A; g.Bt = Bt; g.M = M; g.N = N; g.K = Kv; g.lda = lda; g.ldb = ldb;
    if (lda == 64) { g.kstepA = 256 * 64 * 2; g.hstepA = 128 * 64 * 2; g.tstepA = (size_t)(K / 64) * (256 * 64 * 2); }
    else { g.kstepA = 128; g.hstepA = (size_t)128 * lda * 2; g.tstepA = (size_t)256 * lda * 2; }
    pg8::StaticOrder S; S.init(M, N, G, c);
    pg8::gemm_phase<Epi>(lds, g, S, E, tid);
}
constexpr int NPHASE = 21;
__global__ void __launch_bounds__(512, 2) mega(const Params p_unused) {
    KP p0 = (KP)__builtin_amdgcn_kernarg_segment_ptr();
    extern __shared__ __attribute__((aligned(16))) unsigned char shm[];
    LAS unsigned char* lds = (LAS unsigned char*)shm;
    cg::grid_group grid = cg::this_grid();
    volatile LAS unsigned* xst = (volatile LAS unsigned*)(lds + 147456);
    if (threadIdx.x == 0) { xst[0] = 0u; xst[1] = 0u; xst[2] = 0u; xst[3] = 0u; }
    __syncthreads();
    const XcdBarrier xb = xcd_barrier_post((unsigned*)(p0->ws + WS_BAR), xst);
    const int ph_hi = p0->ph_hi;
    const int wid_s = __builtin_amdgcn_readfirstlane((int)threadIdx.x >> 6);
    { int tid0 = threadIdx.x, bc0 = blockIdx.x, G0 = gridDim.x; asm volatile("" : "+v"(tid0)); asm volatile("" : "+s"(bc0)); asm volatile("" : "+s"(G0)); phase_prep(p0, lds, tid0, bc0, G0); }
    grid.sync();
    for (int phi = 1; phi < ph_hi; ++phi) {
        int ph = phi;
#ifdef PROBE_PH
        if (phi > PROBE_PH) ph = phi - 1;
#endif
        KP p = p0; asm volatile("" : "+s"(p));
        unsigned char* ws = p->ws;
        const float* cosT = (const float*)(ws + WS_ROPEC); const float* sinT = (const float*)(ws + WS_ROPES);
        bf16_t* U = (bf16_t*)(p->out); bf16_t* HID = (bf16_t*)(ws + WS_HID); unsigned short* H16 = (unsigned short*)(ws + WS_H16);
        float* ssq = (float*)(ws + WS_SSPA); const float* bv = (const float*)(ws + WS_BV); const float* gsv = (const float*)(ws + WS_GS);
        unsigned zz = 0u; asm volatile("" : "+v"(zz));
        int tid = (wid_s << 6) | (int)__builtin_amdgcn_mbcnt_hi(~0u, __builtin_amdgcn_mbcnt_lo(~0u, zz)), bc = blockIdx.x, G = gridDim.x;
        asm volatile("" : "+v"(tid)); asm volatile("" : "+s"(bc)); asm volatile("" : "+s"(G));
        if (phi > 1) xcd_barrier(xb, tid);
        switch (ph) {
        case 1: phase_modfinal(p, tid, bc, G); break;
        case 2: phase_bias(p, lds, tid, bc, G); break;
        case 3: { EpiSwiGLU e{HID, ssq + 0 * NTOK, bv + 0 * BV_FFN}; run_gemm(tid, lds, U, DM, (const bf16_t*)(ws + WS_WIN) + (size_t)0 * 5632 * DM, DM, NTOK, 5632, DM, e, G, bc); } break;
        case 4: { EpiResidN<false, true> e{p->x, H16, modp(p, 0, 0, 2), 0.5f, ssq + 1 * NTOK, U, gsv + 1 * 4096, U, gsv + 1 * 4096}; run_gemm(tid, lds, HID, 64, (const bf16_t*)(ws + WS_WOUT) + (size_t)0 * DM * DFF, DFF, NTOK, DM, DFF, e, G, bc); } break;
        case 5: case 7: case 9: { const int g = (ph - 5) >> 1;
            EpiQKV e{(bf16_t*)(ws + WS_QKVG), p->a_q_gain + g * 64, p->a_k_gain + g * 64, cosT, sinT, ssq + 1 * NTOK, bv + BV_QKV, g * 3072};
            run_gemm(tid, lds, U, DM, (const bf16_t*)(ws + WS_WQKV) + (size_t)g * 3072 * DM, DM, NTOK, 3072, DM, e, G, bc); } break;
        case 6: case 8: case 10: phase_dilated(p, lds, (ph - 6) >> 1, tid, bc, G); break;
        case 11: { EpiResidN<false, false> e{H16, H16, modp(p, 0, 1, 2), 1.0f, ssq + 2 * NTOK, U, gsv + 2 * 4096, U, gsv + 2 * 4096}; run_gemm(tid, lds, (const bf16_t*)(ws + WS_OACC), DM, (const bf16_t*)(ws + WS_WOA), DM, NTOK, DM, DM, e, G, bc); } break;
        case 12: { EpiSwiGLU e{HID, ssq + 2 * NTOK, bv + 1 * BV_FFN}; run_gemm(tid, lds, U, DM, (const bf16_t*)(ws + WS_WIN) + (size_t)1 * 5632 * DM, DM, NTOK, 5632, DM, e, G, bc); } break;
        case 13: { EpiResidN<true, false> e{H16, H16, modp(p, 0, 2, 2), 0.5f, ssq + 3 * NTOK, U, gsv + 3 * 4096, (bf16_t*)(ws + WS_UKV), gsv + 4 * 4096}; run_gemm(tid, lds, HID, 64, (const bf16_t*)(ws + WS_WOUT) + (size_t)1 * DM * DFF, DFF, NTOK, DM, DFF, e, G, bc); } break;
        case 14: { EpiKV ek{(bf16_t*)(ws + WS_KV), p->kv_k_gain, cosT, sinT, ssq + 3 * NTOK, bv + BV_KV}; run_gemm(tid, lds, (const bf16_t*)(ws + WS_UKV), DM, (const bf16_t*)(ws + WS_WKV), DM, NTOK, 768, DM, ek, G, bc);
                   EpiSwiGLU e{HID, ssq + 3 * NTOK, bv + 2 * BV_FFN}; run_gemm(tid, lds, U, DM, (const bf16_t*)(ws + WS_WIN) + (size_t)2 * 5632 * DM, DM, NTOK, 5632, DM, e, G, bc); } break;
        case 15: { if (bc < 32) { const int which = bc >> 4; EpiCmp1 ec{(bf16_t*)(ws + WS_HC) + (size_t)which * 4096 * 256, (const float*)(ws + WS_BIAS1) + which * 128};
                       run_gemm(tid, lds, (const bf16_t*)(ws + WS_KV) + (size_t)which * 4096 * 1024, 1024, (const bf16_t*)(ws + WS_WPHI1) + (size_t)which * 256 * 2048, 2048, 4096, 256, 2048, ec, 16, bc & 15); }
                   EpiResidN<false, false> e{H16, H16, modp(p, 1, 0, 2), 0.5f, ssq + 5 * NTOK, U, gsv + 5 * 4096, U, gsv + 5 * 4096}; run_gemm(tid, lds, HID, 64, (const bf16_t*)(ws + WS_WOUT) + (size_t)2 * DM * DFF, DFF, NTOK, DM, DFF, e, G, bc); } break;
        case 16: { if (bc >= 128 && bc < 144) { EpiCmp2<true> ec{
(bf16_t*)(ws + WS_CMP), p->kv_k_gain};
                       run_gemm(tid, lds, (const bf16_t*)(ws + WS_HC), 256, (const bf16_t*)(ws + WS_WPHI2), 256, 4096, 256, 256, ec, 16, bc & 15); }
                   else if (bc >= 144 && bc < 160) { EpiCmp2<false> ec{(bf16_t*)(ws + WS_CMP) + (size_t)4096 * 64, p->kv_k_gain};
                       run_gemm(tid, lds, (const bf16_t*)(ws + WS_HC) + (size_t)4096 * 256, 256, (const bf16_t*)(ws + WS_WPHI2) + (size_t)256 * 256, 256, 4096, 256, 256, ec, 16, bc & 15); }
                   EpiQG e{(bf16_t*)(ws + WS_QN), (bf16_t*)(ws + WS_QR), (float*)(ws + WS_GATES), p->b_q_gain, cosT, sinT, ssq + 5 * NTOK, bv + BV_QG};
                   run_gemm(tid, lds, U, DM, (const bf16_t*)(ws + WS_WQG), DM, NTOK, 1280, DM, e, G, bc); } break;
        case 17: phase_nsa(p, lds, tid, bc, G); break;
        case 18: { EpiResidN<false, false> e{H16, H16, modp(p, 1, 1, 2), 1.0f, ssq + 6 * NTOK, U, gsv + 6 * 4096, U, gsv + 6 * 4096}; run_gemm(tid, lds, (const bf16_t*)(ws + WS_UKV), DM, (const bf16_t*)(ws + WS_WOB), DM, NTOK, DM, DM, e, G, bc); } break;
        case 19: { EpiSwiGLU e{HID, ssq + 3 * NTOK + 3 * NTOK, bv + 3 * BV_FFN}; run_gemm(tid, lds, U, DM, (const bf16_t*)(ws + WS_WIN) + (size_t)3 * 5632 * DM, DM, NTOK, 5632, DM, e, G, bc); } break;
        case 20: { EpiResid e{H16, p->out, modp(p, 1, 2, 2), 0.5f}; run_gemm(tid, lds, HID, 64, (const bf16_t*)(ws + WS_WOUT) + (size_t)3 * DM * DFF, DFF, NTOK, DM, DFF, e, G, bc); } break;
        default: break;
        }
    }
}

static void set_job(Job& j, const float* src, bf16_t* dst, int nsrc, int ksrc, int kdst, int ndst, int perm) { j.src = src; j.dst = dst; j.nsrc = nsrc; j.ksrc = ksrc; j.kdst = kdst; j.ndst = ndst; j.perm = perm; j.pad = 0; }
extern "C" void kernel_launch(void* const* d_in, const int* in_sizes, int n_in, void* d_out, int out_size, void* d_ws, size_t ws_size, hipStream_t stream) {
    static int grid_blocks = 0;
    if (grid_blocks == 0) {
        if (n_in != 22 || ws_size < WS_NEED) { fprintf(stderr, "kernel_launch: unexpected inputs (%d) or workspace (%zu)\n", n_in, ws_size); grid_blocks = -1; return; }
        int dev = 0, cus = 0, per_cu = 0;
        (void)hipGetDevice(&dev); (void)hipDeviceGetAttribute(&cus, hipDeviceAttributeMultiprocessorCount, dev);
        if (hipFuncSetAttribute((const void*)mega, hipFuncAttributeMaxDynamicSharedMemorySize, LDS_BYTES) != hipSuccess) { fprintf(stderr, "kernel_launch: hipFuncSetAttribute failed\n"); grid_blocks = -1; return; }
        if (hipOccupancyMaxActiveBlocksPerMultiprocessor(&per_cu, (const void*)mega, 512, LDS_BYTES) != hipSuccess || per_cu < 1) { fprintf(stderr, "kernel_launch: occupancy query says %d\n", per_cu); per_cu = 1; }
        (void)hipGetLastError();
        grid_blocks = cus * 1;
    }
    if (grid_blocks < 0) return;
    Params p; memset(&p, 0, sizeof(p));
    const float* const* in = (const float* const*)d_in;
    p.x = in[0]; p.c = in[1]; p.norm_g = in[2]; p.w_ada = in[3]; p.b_ada = in[4]; p.ffn_w_in = in[5]; p.ffn_w_out = in[6]; p.a_w_qkv = in[7]; p.a_q_gain = in[8]; p.a_k_gain = in[9];
    p.a_w_o = in[10]; p.kv_norm_g = in[11]; p.w_ada_kv = in[12]; p.b_ada_kv = in[13]; p.w_kv = in[14]; p.kv_k_gain = in[15]; p.cmp_pos = in[16]; p.phi_w1 = in[17]; p.phi_w2 = in[18];
    p.b_w_qg = in[19]; p.b_q_gain = in[20]; p.b_w_o = in[21];
    p.out = (float*)d_out; p.ws = (unsigned char*)d_ws;
    unsigned char* ws = (unsigned char*)d_ws;
    int j = 0;
    for (int i = 0; i < 4; ++i) set_job(p.jobs[j++], p.ffn_w_in + (size_t)i * DM * 5632, (bf16_t*)(ws + WS_WIN) + (size_t)i * 5632 * DM, 5632, DM, DM, 5632, 2);
    for (int i = 0; i < 4; ++i) set_job(p.jobs[j++], p.ffn_w_out + (size_t)i * DFF * DM, (bf16_t*)(ws + WS_WOUT) + (size_t)i * DM * DFF, DM, DFF, DFF, DM, 0);
    set_job(p.jobs[j++], p.a_w_qkv, (bf16_t*)(ws + WS_WQKV), 9216, DM, DM, 9216, 1);
    set_job(p.jobs[j++], p.a_w_o, (bf16_t*)(ws + WS_WOA), DM, DM, DM, DM, 0);
    set_job(p.jobs[j++], p.w_kv, (bf16_t*)(ws + WS_WKV), 768, DM, DM, 768, 1);
    set_job(p.jobs[j++], p.b_w_qg, (bf16_t*)(ws + WS_WQG), 1072, DM, DM, 1280, 3);
    set_job(p.jobs[j++], p.b_w_o, (bf16_t*)(ws + WS_WOB), DM, DM, DM, DM, 0);
    for (int i = 0; i < 2; ++i) set_job(p.jobs[j++], p.phi_w1 + (size_t)i * 2048 * 128, (bf16_t*)(ws + WS_WPHI1) + (size_t)i * 256 * 2048, 128, 2048, 2048, 256, 0);
    for (int i = 0; i < 2; ++i) set_job(p.jobs[j++], p.phi_w2 + (size_t)i * 128 * 64, (bf16_t*)(ws + WS_WPHI2) + (size_t)i * 256 * 256, 64, 128, 256, 256, 1);
    p.ph_lo = 0; p.ph_hi = NPHASE;
#ifdef PROBE_PH
    p.ph_hi = NPHASE + 1;
#endif
    if (hipMemsetAsync(ws + WS_BAR, 0, XCD_BAR_WORDS * 4, stream) != hipSuccess) { fprintf(stderr, "kernel_launch: memset of barrier words failed\n"); return; }
    void* args[] = {(void*)&p};
    hipError_t e = hipLaunchCooperativeKernel((const void*)mega, dim3(grid_blocks), dim3(512), args, LDS_BYTES, stream);
    if (e != hipSuccess) fprintf(stderr, "cooperative launch failed: %s (grid %d)\n", hipGetErrorString(e), grid_blocks);
}
```
